# Optimizing an MI355X kernel written in HIP

```python
import math
import jax, jax.numpy as jnp
from jax import lax
import numpy as np

D_MODEL = 1024
BATCH = 8
SEQ = 2048
DEPTH = 4
DEC_BATCH = 128
DEC_SEQ = 8
PAST_LEN = 8192
PAGE_SIZE = 128

N_MIXERS = 3
N_ATTN_LAYERS = (DEPTH + 2) // 3
N_SSM_LAYERS = (DEPTH + 1) // 3
N_POOL_LAYERS = DEPTH // 3

HEAD_DIM = 64
N_HEADS = D_MODEL // HEAD_DIM
N_KV_HEADS = 4
GQA_GROUP = N_HEADS // N_KV_HEADS
WINDOW = 128
BLOCK_Q = 128
Q_DIM = N_HEADS * HEAD_DIM
KV_DIM = N_KV_HEADS * HEAD_DIM
QKV_DIM = Q_DIM + 2 * KV_DIM
REL_BUCKETS = 32
REL_MAX_DIST = 128

D_INNER = 2 * D_MODEL
SSM_HEAD_DIM = 64
SSM_HEADS = D_INNER // SSM_HEAD_DIM
SSM_GROUPS = 4
SSM_HEADS_PER_GROUP = SSM_HEADS // SSM_GROUPS
D_STATE = 128
CONV_WIDTH = 4
CONV_DIM = D_INNER + 2 * SSM_GROUPS * D_STATE
SSM_IN_DIM = D_INNER + CONV_DIM + SSM_HEADS
SSD_CHUNK = 128
RMS_EPS = 1e-5

POOL_WINDOWS = (2, 4, 8, 16)
POOL_GROUPS = len(POOL_WINDOWS)
POOL_GROUP_DIM = D_MODEL // POOL_GROUPS
POOL_STATE_LEN = max(POOL_WINDOWS) - 1

D_FF = -(-8 * D_MODEL // (3 * 256)) * 256

DEEPNORM_ALPHA = (2 * DEPTH) ** 0.25
DEEPNORM_BETA = (8 * DEPTH) ** -0.25
LN_EPS = 1e-5

kernel_name = 'hybrid_swa_ssd_pool_decoder_step'


def _layer_norm(x, g, b):
    xf = x.astype(jnp.float32)
    mu = xf.mean(-1, keepdims=True)
    var = jnp.square(xf - mu).mean(-1, keepdims=True)
    return (xf - mu) * lax.rsqrt(var + LN_EPS) * g + b


def _swiglu(x, wg, wu, wd):
    return (jax.nn.silu(x @ wg) * (x @ wu)) @ wd


def _t5_bucket(dist):
    n = jnp.maximum(dist, 0)
    max_exact = REL_BUCKETS // 2
    nf = jnp.maximum(n, 1).astype(jnp.float32)
    large = max_exact + (jnp.log(nf / max_exact) / math.log(REL_MAX_DIST / max_exact)
                         * (REL_BUCKETS - max_exact)).astype(jnp.int32)
    large = jnp.minimum(large, REL_BUCKETS - 1)
    return jnp.where(n < max_exact, n, large)


def _qkv(x, w_qkv, b_qkv):
    h = x @ w_qkv + b_qkv
    lead = x.shape[:-1]
    q = h[..., :Q_DIM].reshape(*lead, N_KV_HEADS, GQA_GROUP, HEAD_DIM)
    k = h[..., Q_DIM:Q_DIM + KV_DIM].reshape(*lead, N_KV_HEADS, HEAD_DIM)
    v = h[..., Q_DIM + KV_DIM:].reshape(*lead, N_KV_HEADS, HEAD_DIM)
    return q, k, v


def _sink_attention(q, k, v, dist, valid, rel_bias, sinks):
    s = jnp.einsum('...qkgd,...skd->...kgqs', q, k).astype(jnp.float32) * (HEAD_DIM ** -0.5)
    bias = rel_bias.astype(jnp.float32)[_t5_bucket(dist)]
    bias = jnp.moveaxis(bias, -1, 0).reshape(N_KV_HEADS, GQA_GROUP, *dist.shape)
    s = jnp.where(valid, s + bias, -jnp.inf)
    sink = sinks.astype(jnp.float32).reshape(N_KV_HEADS, GQA_GROUP, 1, 1)
    m = jnp.maximum(s.max(-1, keepdims=True), sink)
    p = jnp.exp(s - m)
    w = p / (p.sum(-1, keepdims=True) + jnp.exp(sink - m))
    return jnp.einsum('...kgqs,...skd->...qkgd', w, v.astype(jnp.float32))


def _swa_prompt(x, w_qkv, b_qkv, w_o, b_o, sinks, rel_bias):
    b, l, _ = x.shape
    nb = l // BLOCK_Q
    q, k, v = _qkv(x, w_qkv, b_qkv)
    qb = q.reshape(b, nb, BLOCK_Q, N_KV_HEADS, GQA_GROUP, HEAD_DIM)

    def band(t):
        tb = t.reshape(b, nb, BLOCK_Q, N_KV_HEADS, HEAD_DIM)
        prev = jnp.concatenate([jnp.zeros_like(tb[:, :1]), tb[:, :-1]], axis=1)
        return jnp.concatenate([prev, tb], axis=2)

    qi = jnp.arange(BLOCK_Q, dtype=jnp.int32)
    si = jnp.arange(2 * BLOCK_Q, dtype=jnp.int32)
    dist = qi[:, None] + BLOCK_Q - si[None, :]
    kpos = jnp.arange(nb, dtype=jnp.int32)[:, None] * BLOCK_Q + si[None, :] - BLOCK_Q
    valid = (dist >= 0) & (dist < WINDOW) & (kpos[:, None, :] >= 0)
    o = _sink_attention(qb, band(k), band(v), dist, valid[:, None, None], rel_bias, sinks)
    y = o.reshape(b, l, Q_DIM) @ w_o + b_o
    return y, k[:, -WINDOW:], v[:, -WINDOW:]


def _swa_sample(x, k_buf, v_buf, start, w_qkv, b_qkv, w_o, b_o, sinks, rel_bias):
    b, l, _ = x.shape
    q, k, v = _qkv(x, w_qkv, b_qkv)
    k_all = jnp.concatenate([k_buf.astype(k.dtype), k], axis=1)
    v_all = jnp.concatenate([v_buf.astype(v.dtype), v], axis=1)
    qpos = start + jnp.arange(l, dtype=jnp.int32)
    kpos = start - WINDOW + jnp.arange(WINDOW + l, dtype=jnp.int32)
    dist = qpos[:, None] - kpos[None, :]
    valid = (dist >= 0) & (dist < WINDOW)
    o = _sink_attention(q, k_all, v_all, dist, valid, rel_bias, sinks)
    y = o.reshape(b, l, Q_DIM) @ w_o + b_o
    return y, k_all[:, -WINDOW:], v_all[:, -WINDOW:]


def _ssd_scan(x, dt, a, bm, cm, h0, chunk):
    b, l = x.shape[:2]
    nc = l // chunk

    def to_chunks(t):
        return jnp.moveaxis(t.astype(jnp.float32).reshape(b, nc, chunk, *t.shape[2:]), 1, 0)

    causal = jnp.tril(jnp.ones((chunk, chunk), dtype=bool))[None, :, :, None, None]

    def step(h, inp):
        xc, dtc, bc, cc = inp
        acum = jnp.cumsum(dtc * a, axis=1)
        seg = acum[:, :, None] - acum[:, None, :]
        lmat = jnp.exp(jnp.where(causal, seg, -jnp.inf))
        cb = jnp.einsum('btgn,bsgn->btsg', cc, bc)
        w = cb[..., None] * lmat * dtc[:, None]
        y = jnp.einsum('btsgr,bsgrp->btgrp', w, xc)
        y = y + jnp.einsum('btgn,bgrpn->btgrp', cc, h) * jnp.exp(acum)[..., None]
        decay = jnp.exp(acum[:, -1:] - acum) * dtc
        h = h * jnp.exp(acum[:, -1])[..., None, None] + jnp.einsum('bsgn,bsgrp->bgrpn', bc, decay[..., None] * xc)
        return h, y

    h, ys = lax.scan(step, h0, (to_chunks(x), to_chunks(dt), to_chunks(bm), to_chunks(cm)))
    return jnp.moveaxis(ys, 0, 1).reshape(x.shape), h


def _mamba2(x, conv_state, ssm_state, w_in, conv_w, conv_b, dt_bias, a_log, d_skip, norm_w, w_out):
    b, l, _ = x.shape
    zxbcdt = x @ w_in
    z = zxbcdt[..., :D_INNER]
    xbc = zxbcdt[..., D_INNER:D_INNER + CONV_DIM]
    dt = zxbcdt[..., D_INNER + CONV_DIM:]
    xpad = jnp.concatenate([conv_state.astype(xbc.dtype), xbc], axis=1)
    conv = conv_b + sum(xpad[:, j:j + l] * conv_w[j] for j in range(CONV_WIDTH))
    xbc = jax.nn.silu(conv)
    gbn = SSM_GROUPS * D_STATE
    xs = xbc[..., :D_INNER].reshape(b, l, SSM_GROUPS, SSM_HEADS_PER_GROUP, SSM_HEAD_DIM)
    bm = xbc[..., D_INNER:D_INNER + gbn].reshape(b, l, SSM_GROUPS, D_STATE)
    cm = xbc[..., D_INNER + gbn:].reshape(b, l, SSM_GROUPS, D_STATE)
    dt = jax.nn.softplus(dt.astype(jnp.float32) + dt_bias).reshape(b, l, SSM_GROUPS, SSM_HEADS_PER_GROUP)
    a = -jnp.exp(a_log.astype(jnp.float32)).reshape(SSM_GROUPS, SSM_HEADS_PER_GROUP)
    h0 = ssm_state.astype(jnp.float32).reshape(b, SSM_GROUPS, SSM_HEADS_PER_GROUP, SSM_HEAD_DIM, D_STATE)
    y, h = _ssd_scan(xs, dt, a, bm, cm, h0, min(SSD_CHUNK, l))
    y = y + d_skip.reshape(SSM_GROUPS, SSM_HEADS_PER_GROUP, 1) * xs
    y = y.reshape(b, l, D_INNER) * jax.nn.silu(z.astype(jnp.float32))
    yg = y.reshape(b, l, SSM_GROUPS, D_INNER // SSM_GROUPS)
    yg = yg * lax.rsqrt(jnp.mean(yg * yg, -1, keepdims=True) + RMS_EPS)
    y = yg.reshape(b, l, D_INNER) * norm_w
    new_h = h.reshape(b, SSM_HEADS, SSM_HEAD_DIM, D_STATE)
    return y @ w_out, xpad[:, -(CONV_WIDTH - 1):], new_h


def _pool_mixer(x, prefix, start, pool_w, pool_scale):
    b, l, _ = x.shape
    xf = x.astype(jnp.float32)
    xp = jnp.concatenate([prefix.astype(jnp.float32), xf], axis=1)
    cs = jnp.concatenate([jnp.zeros((b, 1, D_MODEL), jnp.float32), jnp.cumsum(xp, axis=1)], axis=1)
    hi = cs[:, POOL_STATE_LEN + 1:]
    pos = start + jnp.arange(l, dtype=jnp.int32)
    outs = []
    for g, w in enumerate(POOL_WINDOWS):
        sl = slice(g * POOL_GROUP_DIM, (g + 1) * POOL_GROUP_DIM)
        lo = cs[:, POOL_STATE_LEN + 1 - w:POOL_STATE_LEN + 1 - w + l, sl]
        cnt = jnp.minimum(pos + 1, w).astype(jnp.float32)[None, :, None]
        diff = (hi[..., sl] - lo) / cnt - xf[..., sl]
        outs.append(diff @ pool_w[g])
    y = jnp.concatenate(outs, axis=-1) * pool_scale
    return y, xp[:, -POOL_STATE_LEN:]


def setup_inputs(seed: int = 0) -> dict:
    key = jax.random.key(seed)
    ks = iter(jax.random.split(key, 32))

    def nrm(shape, scale):
        return jax.random.normal(next(ks), shape, jnp.float32) * scale

    def unif(shape, lo, hi):
        return jax.random.uniform(next(ks), shape, jnp.float32, lo, hi)

    beta = DEEPNORM_BETA
    x_prompt = nrm((BATCH, SEQ, D_MODEL), 1.0)
    x_sample = nrm((DEC_BATCH, DEC_SEQ, D_MODEL), 1.0)
    cache_k = nrm((N_ATTN_LAYERS, DEC_BATCH, WINDOW, N_KV_HEADS, HEAD_DIM), 1.0)
    cache_v = nrm((N_ATTN_LAYERS, DEC_BATCH, WINDOW, N_KV_HEADS, HEAD_DIM), beta)
    state_conv = nrm((N_SSM_LAYERS, DEC_BATCH, CONV_WIDTH - 1, CONV_DIM), 1.0)
    state_ssm = nrm((N_SSM_LAYERS, DEC_BATCH, SSM_HEADS, SSM_HEAD_DIM, D_STATE), 0.1)
    state_pool = nrm((N_POOL_LAYERS, DEC_BATCH, POOL_STATE_LEN, D_MODEL), 1.0)
    rel_bias = nrm((REL_BUCKETS, N_HEADS), 0.5)
    w_qk = nrm((N_ATTN_LAYERS, D_MODEL, Q_DIM + KV_DIM), D_MODEL ** -0.5)
    w_v = nrm((N_ATTN_LAYERS, D_MODEL, KV_DIM), D_MODEL ** -0.5 * beta)
    attn_w_qkv = jnp.concatenate([w_qk, w_v], axis=-1)
    attn_b_qkv = nrm((N_ATTN_LAYERS, QKV_DIM), 0.02)
    attn_w_o = nrm((N_ATTN_LAYERS, Q_DIM, D_MODEL), Q_DIM ** -0.5 * beta)
    attn_b_o = nrm((N_ATTN_LAYERS, D_MODEL), 0.02)
    attn_sinks = nrm((N_ATTN_LAYERS, N_HEADS), 1.0)
    ssm_w_in = nrm((N_SSM_LAYERS, D_MODEL, SSM_IN_DIM), D_MODEL ** -0.5)
    ssm_conv_w = nrm((N_SSM_LAYERS, CONV_WIDTH, CONV_DIM), CONV_WIDTH ** -0.5)
    ssm_conv_b = nrm((N_SSM_LAYERS, CONV_DIM), 0.02)
    dt0 = jnp.exp(unif((N_SSM_LAYERS, SSM_HEADS), math.log(1e-3), math.log(1e-1)))
    ssm_dt_bias = dt0 + jnp.log(-jnp.expm1(-dt0))
    ssm_a_log = jnp.log(unif((N_SSM_LAYERS, SSM_HEADS), 1.0, 16.0))
    ssm_d = 1.0 + nrm((N_SSM_LAYERS, SSM_HEADS), 0.02)
    ssm_norm_w = 1.0 + nrm((N_SSM_LAYERS, D_INNER), 0.02)
    ssm_w_out = nrm((N_SSM_LAYERS, D_INNER, D_MODEL), D_INNER ** -0.5 * beta)
    pool_w = nrm((N_POOL_LAYERS, POOL_GROUPS, POOL_GROUP_DIM, POOL_GROUP_DIM), POOL_GROUP_DIM ** -0.5 * beta)
    pool_scale = 1.0 + nrm((N_POOL_LAYERS, D_MODEL), 0.02)
    ffn_w_gate = nrm((DEPTH, D_MODEL, D_FF), D_MODEL ** -0.5 * beta)
    ffn_w_up = nrm((DEPTH, D_MODEL, D_FF), D_MODEL ** -0.5 * beta)
    ffn_w_down = nrm((DEPTH, D_FF, D_MODEL), D_FF ** -0.5 * beta)
    ln_g = 1.0 + nrm((DEPTH, 2, D_MODEL), 0.02)
    ln_b = nrm((DEPTH, 2, D_MODEL), 0.02)
    return {'x_prompt': x_prompt, 'x_sample': x_sample, 'cache_k': cache_k, 'cache_v': cache_v,
            'state_conv': state_conv, 'state_ssm': state_ssm, 'state_pool': state_pool,
            'rel_bias': rel_bias, 'attn_w_qkv': attn_w_qkv, 'attn_b_qkv': attn_b_qkv,
            'attn_w_o': attn_w_o, 'attn_b_o': attn_b_o, 'attn_sinks': attn_sinks,
            'ssm_w_in': ssm_w_in, 'ssm_conv_w': ssm_conv_w, 'ssm_conv_b': ssm_conv_b,
            'ssm_dt_bias': ssm_dt_bias, 'ssm_a_log': ssm_a_log, 'ssm_d': ssm_d,
            'ssm_norm_w': ssm_norm_w, 'ssm_w_out': ssm_w_out, 'pool_w': pool_w,
            'pool_scale': pool_scale, 'ffn_w_gate': ffn_w_gate, 'ffn_w_up': ffn_w_up,
            'ffn_w_down': ffn_w_down, 'ln_g': ln_g, 'ln_b': ln_b}


def reference(x_prompt, x_sample, cache_k, cache_v, state_conv, state_ssm, state_pool, rel_bias,
              attn_w_qkv, attn_b_qkv, attn_w_o, attn_b_o, attn_sinks, ssm_w_in, ssm_conv_w,
              ssm_conv_b, ssm_dt_bias, ssm_a_log, ssm_d, ssm_norm_w, ssm_w_out, pool_w,
              pool_scale, ffn_w_gate, ffn_w_up, ffn_w_down, ln_g, ln_b):
    xp, xs = x_prompt, x_sample
    bp = xp.shape[0]
    nk_p, nv_p, nc_p, nh_p, npool_p = [], [], [], [], []
    nk_s, nv_s, nc_s, nh_s, npool_s = [], [], [], [], []
    for i in range(DEPTH):
        j = i // N_MIXERS
        kind = i % N_MIXERS
        if kind == 0:
            mp, kp, vp = _swa_prompt(xp, attn_w_qkv[j], attn_b_qkv[j], attn_w_o[j], attn_b_o[j],
                                     attn_sinks[j], rel_bias)
            ms, ks_, vs_ = _swa_sample(xs, cache_k[j], cache_v[j], PAST_LEN, attn_w_qkv[j], attn_b_qkv[j],
                                       attn_w_o[j], attn_b_o[j], attn_sinks[j], rel_bias)
            nk_p.append(kp); nv_p.append(vp); nk_s.append(ks_); nv_s.append(vs_)
        elif kind == 1:
            ssm_args = (ssm_w_in[j], ssm_conv_w[j], ssm_conv_b[j], ssm_dt_bias[j], ssm_a_log[j],
                        ssm_d[j], ssm_norm_w[j], ssm_w_out[j])
            conv0 = jnp.zeros((bp, CONV_WIDTH - 1, CONV_DIM), xp.dtype)
            h0 = jnp.zeros((bp, SSM_HEADS, SSM_HEAD_DIM, D_STATE), jnp.float32)
            mp, cp, hp = _mamba2(xp, conv0, h0, *ssm_args)
            ms, cs_, hs_ = _mamba2(xs, state_conv[j], state_ssm[j], *ssm_args)
            nc_p.append(cp); nh_p.append(hp); nc_s.append(cs_); nh_s.append(hs_)
        else:
            pool0 = jnp.zeros((bp, POOL_STATE_LEN, D_MODEL), jnp.float32)
            mp, pp = _pool_mixer(xp, pool0, 0, pool_w[j], pool_scale[j])
            ms, ps_ = _pool_mixer(xs, state_pool[j], PAST_LEN, pool_w[j], pool_scale[j])
            npool_p.append(pp); npool_s.append(ps_)
        xp = _layer_norm(DEEPNORM_ALPHA * xp + mp, ln_g[i, 0], ln_b[i, 0])
        xs = _layer_norm(DEEPNORM_ALPHA * xs + ms, ln_g[i, 0], ln_b[i, 0])
        xp = _layer_norm(DEEPNORM_ALPHA * xp + _swiglu(xp, ffn_w_gate[i], ffn_w_up[i], ffn_w_down[i]),
                         ln_g[i, 1], ln_b[i, 1])
        xs = _layer_norm(DEEPNORM_ALPHA * xs + _swiglu(xs, ffn_w_gate[i], ffn_w_up[i], ffn_w_down[i]),
                         ln_g[i, 1], ln_b[i, 1])
    return (xp, xs,
            jnp.stack(nk_p), jnp.stack(nv_p), jnp.stack(nc_p), jnp.stack(nh_p), jnp.stack(npool_p),
            jnp.stack(nk_s), jnp.stack(nv_s), jnp.stack(nc_s), jnp.stack(nh_s), jnp.stack(npool_s))
```

```cpp
#include <hip/hip_runtime.h>
#include <cstdio>
#include <cstdint>

#define LAS __attribute__((address_space(3)))
#define GAS __attribute__((address_space(1)))
typedef unsigned short bf16_t;
typedef short bf16x8 __attribute__((ext_vector_type(8)));
typedef float f32x4 __attribute__((ext_vector_type(4)));
typedef float f32x2 __attribute__((ext_vector_type(2)));
typedef unsigned u32x4 __attribute__((ext_vector_type(4)));
typedef unsigned u32x2 __attribute__((ext_vector_type(2)));

constexpr int D = 1024;
constexpr int PB = 8, PL = 2048, MP = PB * PL;
constexpr int SB = 128, SL = 8, MS = SB * SL;
constexpr int M = MP + MS;
constexpr int NKV = 4, HD = 64, NHQ = 16, WIN = 128;
constexpr int QKV_N = 1536, KCOL = 1024, VCOL = 1280;
constexpr int FF = 2816, GU_N = 2 * FF;
constexpr int DI = 2048, CONV_D = 3072, SSM_IN = 5152, SSM_INP = 5376, SH = 32, SP = 64, SN = 128;
constexpr int XBC_COL = 2048, DT_COL = 5120;
constexpr int DEPTH = 4;
constexpr float LN_EPS = 1e-5f, RMS_EPS = 1e-5f;
constexpr float ALPHA = 1.6817928305074290f;

constexpr size_t O_Y = 0;
constexpr size_t O_KP = (size_t)M * D;
constexpr size_t O_VP = O_KP + (size_t)2 * PB * WIN * 256;
constexpr size_t O_CP = O_VP + (size_t)2 * PB * WIN * 256;
constexpr size_t O_SP = O_CP + (size_t)PB * 3 * CONV_D;
constexpr size_t O_PP = O_SP + (size_t)PB * SH * SP * SN;
constexpr size_t O_KS = O_PP + (size_t)PB * 15 * D;
constexpr size_t O_VS = O_KS + (size_t)2 * SB * WIN * 256;
constexpr size_t O_CS = O_VS + (size_t)2 * SB * WIN * 256;
constexpr size_t O_SS = O_CS + (size_t)SB * 3 * CONV_D;
constexpr size_t O_PS = O_SS + (size_t)SB * SH * SP * SN;
constexpr size_t O_END = O_PS + (size_t)SB * 15 * D;
static_assert(O_END == 74645504, "output size");

constexpr size_t MiB = 1u << 20;
constexpr size_t WS_CTL = 0, CTL_ZERO_BYTES = 1 * MiB;
constexpr size_t WS_WQKV = 1 * MiB;
constexpr size_t WS_WO = WS_WQKV + 6 * MiB;
constexpr size_t WS_WIN = WS_WO + 4 * MiB;
constexpr size_t WS_WOUT = WS_WIN + 11 * MiB;
constexpr size_t WS_WPOOL = WS_WOUT + 4 * MiB;
constexpr size_t WS_WGU = WS_WPOOL + 1 * MiB;
constexpr size_t WS_WD = WS_WGU + 44 * MiB;
constexpr size_t WS_XB = WS_WD + 22 * MiB;
constexpr size_t WS_Z = WS_XB + 34 * MiB;
constexpr size_t WS_BIG = WS_Z + 68 * MiB;
constexpr size_t WS_QKV = WS_BIG;
constexpr size_t WS_O = WS_BIG + 52 * MiB;
constexpr size_t WS_H = WS_BIG;
constexpr size_t WS_ZX = WS_BIG;
constexpr size_t WS_Y = WS_BIG + 180 * MiB;
constexpr size_t WS_DIFF = WS_BIG;
constexpr size_t WS_END = WS_BIG + 250 * MiB;
static_assert(WS_END <= 512 * MiB, "d_ws map");

__device__ __forceinline__ unsigned f2bf(float f) { unsigned u = __builtin_bit_cast(unsigned, f); return (u + 0x7fffu + ((u >> 16) & 1u)) >> 16; }
__device__ __forceinline__ unsigned pk2(float lo, float hi) { return f2bf(lo) | (f2bf(hi) << 16); }
__device__ __forceinline__ float bflo(unsigned w) { return __builtin_bit_cast(float, w << 16); }
__device__ __forceinline__ float bfhi(unsigned w) { return __builtin_bit_cast(float, w & 0xffff0000u); }
__device__ __forceinline__ float bf1(bf16_t h) { return __builtin_bit_cast(float, (unsigned)h << 16); }
__device__ __forceinline__ float silu_f(float x) { return x / (1.0f + __expf(-x)); }
__device__ __forceinline__ float wave_sum(float v) {
#pragma unroll
    for (int o = 1; o < 64; o <<= 1) v += __shfl_xor(v, o);
    return v;
}
__device__ __forceinline__ float wave_max(float v) {
#pragma unroll
    for (int o = 1; o < 64; o <<= 1) v = fmaxf(v, __shfl_xor(v, o));
    return v;
}

namespace pg8 {
#define PG8_LAS __attribute__((address_space(3)))
constexpr int BM = 256, BK = 64, HALF = 128, HTB = HALF * BK * 2  , STAGE_BYTES = 8 * HTB, NXCD = 8, WGM = 8;

__host__ __device__ __forceinline__ int lds_byte(int r, int c) { const int st = (r >> 4) * 2 + (c >> 5), rr = r & 15, cc = c & 31, ob = rr * 64 + cc * 2; return st * 1024 + (ob ^ (((ob >> 9) & 1) << 5)); }
__host__ __device__ __forceinline__ void stage_rc(int b, int& R, int& C) { const int st = b / 1024, sb = b % 1024, swz = sb ^ (((sb >> 9) & 1) << 5); R = (st >> 1) * 16 + swz / 64; C = (st & 1) * 32 + (swz % 64) / 2; }
__host__ __device__ __forceinline__ int perm32(int rho) { const int n = rho >> 4, i = rho & 15; return 8 * (i >> 2) + 4 * n + (i & 3); }

struct Unit { int pm, pn; };
struct Gemm { const bf16_t* A; const bf16_t* Bt; int M, N, K, lda, ldb; size_t a_pn_bytes; };

struct StaticOrder {
    int nM, nN, nwg, G, c;
    __host__ __device__ void init(int M_, int N_, int G_, int c_) { nM = M_ / BM; nN = N_ / BM; nwg = nM * nN; G = G_; c = c_; }
    __host__ __device__ bool next(int i, Unit& u) const {
        const long L = (long)i * G + c; if (L >= nwg) return false;
        int wgid = (int)L; { const int q = nwg / NXCD, r = nwg % NXCD, xcd = wgid % NXCD, off = wgid / NXCD; wgid = (xcd < r ? xcd * (q + 1) : r * (q + 1) + (xcd - r) * q) + off; }
        const int nig = WGM * nN, gid = wgid / nig, fm = gid * WGM, gsz = (nM - fm) < WGM ? (nM - fm) : WGM;
        u.pm = fm + ((wgid % nig) % gsz); u.pn = (wgid % nig) / gsz; return true;
    }
    __device__ __forceinline__ void a_ready(const Unit&) const {}
    __device__ __forceinline__ void done(const Unit&) const {}
};


struct EpiBf16Side {
    static constexpr bool PERM = true, AFTER_DRAIN = false;
    bf16_t* O; const float* bias; float* out; int mode, j;
    __device__ __forceinline__ void operator()(const f32x4 (&acc)[2][2][4][2], const Unit& u, int wr, int wc, int fr, int fq) const {
        const int ldc = mode == 0 ? QKV_N : SSM_INP;
        const int side_lo = mode == 0 ? KCOL : XBC_COL, side_hi = mode == 0 ? QKV_N : DT_COL, split = mode == 0 ? VCOL : (1 << 30), side_w = mode == 0 ? 256 : CONV_D;
        const int tailP = mode == 0 ? WIN : 3, rowsP = tailP, tailS = mode == 0 ? SL : 3, rowsS = mode == 0 ? WIN : 3;
        const int colt = u.pn * BM;
        const int c8 = colt + wc * 32 + 8 * fq;
        f32x4 bv[2][2];
#pragma unroll
        for (int bj = 0; bj < 2; ++bj)
#pragma unroll
            for (int n = 0; n < 2; ++n) bv[bj][n] = bias ? *(const f32x4*)(bias + c8 + bj * HALF + 4 * n) : (f32x4){0.f, 0.f, 0.f, 0.f};
        const bool has_side = (colt >= side_lo) && (colt < side_hi);
        const bool second = colt >= split;
        const int corg = second ? split : side_lo;
        float* sideP = out + (mode == 0 ? (second ? O_VP : O_KP) + (size_t)j * PB * WIN * 256 : O_CP);
        float* sideS = out + (mode == 0 ? (second ? O_VS : O_KS) + (size_t)j * SB * WIN * 256 : O_CS);
#pragma unroll
        for (int ai = 0; ai < 2; ++ai)
#pragma unroll
            for (int m = 0; m < 4; ++m) {
                const int row = u.pm * BM + ai * HALF + wr * 64 + m * 16 + fr;
                bf16_t* rowp = O + (size_t)row * ldc + c8;
                float* sp = nullptr;
                if (has_side) {
                    if (row < MP) { const int pos = row & (PL - 1), b = row >> 11; if (pos >= PL - tailP) sp = sideP + ((size_t)b * rowsP + (pos - (PL - tailP))) * side_w; }
                    else { const int rs = row - MP, b = rs >> 3, i = rs & 7; if (i >= SL - tailS) sp = sideS + ((size_t)b * rowsS + (rowsS - tailS) + (i - (SL - tailS))) * side_w; }
                }
#pragma unroll
                for (int bj = 0; bj < 2; ++bj) {
                    const f32x4 v0 = acc[ai][bj][m][0] + bv[bj][0], v1 = acc[ai][bj][m][1] + bv[bj][1];
                    u32x4 w; w.x = pk2(v0[0], v0[1]); w.y = pk2(v0[2], v0[3]); w.z = pk2(v1[0], v1[1]); w.w = pk2(v1[2], v1[3]);
                    *(u32x4*)(rowp + bj * HALF) = w;
                    if (sp) { float* q = sp + (c8 + bj * HALF - corg); *(f32x4*)q = v0; *(f32x4*)(q + 4) = v1; }
                }
                asm volatile("" ::: "memory");
            }
    }
};

struct EpiSwiGLU {
    static constexpr bool PERM = true, AFTER_DRAIN = false;
    bf16_t* O; int ldc;
    __device__ __forceinline__ void operator()(const f32x4 (&acc)[2][2][4][2], const Unit& u, int wr, int wc, int fr, int fq) const {
        const int c8 = u.pn * HALF + wc * 32 + 8 * fq;
#pragma unroll
        for (int ai = 0; ai < 2; ++ai)
#pragma unroll
            for (int m = 0; m < 4; ++m) {
                const int row = u.pm * BM + ai * HALF + wr * 64 + m * 16 + fr;
                const f32x4 g0 = acc[ai][0][m][0], g1 = acc[ai][0][m][1], u0 = acc[ai][1][m][0], u1 = acc[ai][1][m][1];
                u32x4 w;
                w.x = pk2(silu_f(g0[0]) * u0[0], silu_f(g0[1]) * u0[1]); w.y = pk2(silu_f(g0[2]) * u0[2], silu_f(g0[3]) * u0[3]);
                w.z = pk2(silu_f(g1[0]) * u1[0], silu_f(g1[1]) * u1[1]); w.w = pk2(silu_f(g1[2]) * u1[2], silu_f(g1[3]) * u1[3]);
                *(u32x4*)(O + (size_t)row * ldc + c8) = w;
                asm volatile("" ::: "memory");
            }
    }
};

struct EpiRes {
    static constexpr bool PERM = false, AFTER_DRAIN = false;
    float* Z; const float* baseP; const float* baseS; const float* bias; const float* scale;
    __device__ __forceinline__ void operator()(const f32x4 (&acc)[2][2][4][2], const Unit& u, int wr, int wc, int fr, int fq) const {
        const int col0 = u.pn * BM + wc * 32 + 4 * fq;
        f32x4 bv[2][2], sv[2][2];
#pragma unroll
        for (int bj = 0; bj < 2; ++bj)
#pragma unroll
            for (int n = 0; n < 2; ++n) {
                bv[bj][n] = bias ? *(const f32x4*)(bias + col0 + bj * HALF + n * 16) : (f32x4){0.f, 0.f, 0.f, 0.f};
                sv[bj][n] = scale ? *(const f32x4*)(scale + col0 + bj * HALF + n * 16) : (f32x4){1.f, 1.f, 1.f, 1.f};
            }
#pragma unroll
        for (int ai = 0; ai < 2; ++ai)
#pragma unroll
            for (int m = 0; m < 4; ++m) {
                const int row = u.pm * BM + ai * HALF + wr * 64 + m * 16 + fr;
                const float* bp = (row < MP ? baseP + (size_t)row * D : baseS + (size_t)(row - MP) * D) + col0;
                float* zp = Z + (size_t)row * D + col0;
#pragma unroll
                for (int bj = 0; bj < 2; ++bj)
#pragma unroll
                    for (int n = 0; n < 2; ++n) {
                        const f32x4 b = *(const f32x4*)(bp + bj * HALF + n * 16);
                        *(f32x4*)(zp + bj * HALF + n * 16) = b * ALPHA + (acc[ai][bj][m][n] + bv[bj][n]) * sv[bj][n];
                    }
                asm volatile("" ::: "memory");
            }
    }
};

template <class Epi, class Sched, bool ALIGN_EPI = false, bool SP2 = false>
__device__ __forceinline__ void gemm_phase(PG8_LAS unsigned char* lds, const Gemm g, const Sched& S, const Epi& E, const int tid) {
    const int wid = __builtin_amdgcn_readfirstlane(tid >> 6), lane = tid & 63, wr = wid >> 2, wc = wid & 3, fr = lane & 15, fq = lane >> 4;
    const int K = g.K, nt = K / BK, lda = g.lda, ldb = g.ldb;
    unsigned voffA[2], voffB[2];
#pragma unroll
    for (int i = 0; i < 2; ++i) { int R, C; stage_rc(tid * 16 + i * 8192, R, C); const int Rb = Epi::PERM ? ((R & ~31) + perm32(R & 31)) : R;
        voffA[i] = (unsigned)(R * lda + C) * 2u; voffB[i] = (unsigned)(Rb * ldb + C) * 2u; }
    const size_t kstep = (size_t)(BK * 2);
    const size_t hstepA = (size_t)HALF * lda * 2, hstepB = (size_t)HALF * ldb * 2;
    const size_t tstepA = 2 * hstepA, tstepB = 2 * hstepB;
    const size_t apn = g.a_pn_bytes;
    const unsigned ldsw = (unsigned)wid * 1024u;
    const int aoff = lds_byte(wr * 64 + fr, fq * 8), boff = lds_byte(wc * 32 + fr, fq * 8);
#define PG8_SA(b, h) (((b) * 2 + (h)) * HTB)
#define PG8_SB(b, h) ((4 + (b) * 2 + (h)) * HTB)
#define PG8_STAGE(bufoff, gbase, voff) do { _Pragma("unroll") for (int _i = 0; _i < 2; ++_i) \
        __builtin_amdgcn_global_load_lds((const unsigned*)((const char*)(gbase) + (voff)[_i]), (PG8_LAS unsigned*)(lds + (bufoff) + ldsw + _i * 8192), 16, 0, 0); } while (0)
#define PG8_LDA(dst, b, h) do { _Pragma("unroll") for (int m = 0; m < 4; ++m) _Pragma("unroll") for (int k = 0; k < 2; ++k) dst[m][k] = *(const PG8_LAS bf16x8*)(lds + PG8_SA(b, h) + aoff + m * 2048 + k * 1024); } while (0)
#define PG8_LDB(dst, b, h) do { _Pragma("unroll") for (int n = 0; n < 2; ++n) _Pragma("unroll") for (int k = 0; k < 2; ++k) dst[n][k] = *(const PG8_LAS bf16x8*)(lds + PG8_SB(b, h) + boff + n * 2048 + k * 1024); } while (0)
#define PG8_MMA(ai, bj, At, Bt) do { __builtin_amdgcn_s_setprio(1); _Pragma("unroll") for (int m = 0; m < 4; ++m) _Pragma("unroll") for (int n = 0; n < 2; ++n) _Pragma("unroll") for (int k = 0; k < 2; ++k) \
        acc[ai][bj][m][n] = __builtin_amdgcn_mfma_f32_16x16x32_bf16(Bt[n][k], At[m][k], acc[ai][bj][m][n], 0, 0, 0); __builtin_amdgcn_s_setprio(0); } while (0)
#define PG8_WAIT_V(n) asm volatile("s_waitcnt vmcnt(" #n ")" ::: "memory")
#define PG8_WAIT_L(n) asm volatile("s_waitcnt lgkmcnt(" #n ")" ::: "memory")
#define PG8_BAR __builtin_amdgcn_s_barrier()
#define PG8_SCHED __builtin_amdgcn_sched_barrier(0)
    Unit cur, nxt; int ui = 0;
    if (!S.next(0, cur)) return;
    f32x4 acc[2][2][4][2];
#pragma unroll
    for (int a = 0; a < 2; ++a)
#pragma unroll
        for (int b = 0; b < 2; ++b)
#pragma unroll
            for (int m = 0; m < 4; ++m)
#pragma unroll
                for (int n = 0; n < 2; ++n) acc[a][b][m][n] = (f32x4){0.f, 0.f, 0.f, 0.f};
    bf16x8 At[4][2], B0[2][2], B1[2][2];
    const char* cA = (const char*)g.A + (size_t)cur.pm * tstepA + (size_t)cur.pn * apn; const char* cB = (const char*)g.Bt + (size_t)cur.pn * tstepB;
    S.a_ready(cur);
    if constexpr (SP2) {
        PG8_STAGE(PG8_SB(0, 0), cB, voffB); PG8_STAGE(PG8_SB(0, 1), cB + hstepB, voffB); PG8_STAGE(PG8_SA(0, 0), cA, voffA); PG8_STAGE(PG8_SA(0, 1), cA + hstepA, voffA);
        if (wr == 1) PG8_BAR;
        PG8_WAIT_V(2); PG8_BAR;
        PG8_STAGE(PG8_SB(1, 0), cB + kstep, voffB); PG8_STAGE(PG8_SA(1, 0), cA + kstep, voffA); PG8_STAGE(PG8_SB(1, 1), cB + hstepB + kstep, voffB);
        PG8_WAIT_V(6); PG8_BAR;
    } else {
        PG8_STAGE(PG8_SB(0, 0), cB, voffB); PG8_STAGE(PG8_SA(0, 0), cA, voffA); PG8_STAGE(PG8_SB(0, 1), cB + hstepB, voffB); PG8_STAGE(PG8_SA(0, 1), cA + hstepA, voffA);
        if (wr == 1) PG8_BAR;
        PG8_WAIT_V(4); PG8_BAR;
        PG8_STAGE(PG8_SB(1, 0), cB + kstep, voffB); PG8_STAGE(PG8_SA(1, 0), cA + kstep, voffA); PG8_STAGE(PG8_SB(1, 1), cB + hstepB + kstep, voffB);
        PG8_WAIT_V(6); PG8_BAR;
    }
    for (;;) {
        const bool has_next = S.next(ui + 1, nxt);
        const char* nA = has_next ? (const char*)g.A + (size_t)nxt.pm * tstepA + (size_t)nxt.pn * apn : cA; const char* nB = has_next ? (const char*)g.Bt + (size_t)nxt.pn * tstepB : cB;
        for (int t = 0; t < nt; t += 2) {
            const bool last = (t == nt - 2);
            const char* a1 = cA + (size_t)(t + 1) * kstep;
            const char* a2 = last ? nA : cA + (size_t)(t + 2) * kstep; const char* b2 = last ? nB : cB + (size_t)(t + 2) * kstep;
            const char* a3 = a2 + kstep; const char* b3 = b2 + kstep;
            if (last && has_next) S.a_ready(nxt);
            if constexpr (SP2) {
            PG8_LDB(B0, 0, 0); PG8_LDB(B1, 0, 1); PG8_SCHED; PG8_LDA(At, 0, 0); PG8_STAGE(PG8_SA(1, 1), a1 + hstepA, voffA);
            PG8_WAIT_V(8); PG8_WAIT_L(0); PG8_BAR; PG8_MMA(0, 0, At, B0); PG8_MMA(0, 1, At, B1); PG8_BAR; PG8_SCHED;
            PG8_LDA(At, 0, 1); PG8_STAGE(PG8_SB(0, 0), b2, voffB); PG8_STAGE(PG8_SB(0, 1), b2 + hstepB, voffB); PG8_STAGE(PG8_SA(0, 0), a2, voffA);
            PG8_WAIT_V(8); PG8_WAIT_L(0); PG8_BAR; PG8_MMA(1, 0, At, B0); PG8_MMA(1, 1, At, B1); PG8_BAR; PG8_SCHED;
            PG8_LDB(B0, 1, 0); PG8_LDB(B1, 1, 1); PG8_SCHED; PG8_LDA(At, 1, 0); PG8_STAGE(PG8_SA(0, 1), a2 + hstepA, voffA);
            PG8_WAIT_V(8); PG8_WAIT_L(0); PG8_BAR; PG8_MMA(0, 0, At, B0); PG8_MMA(0, 1, At, B1); PG8_BAR; PG8_SCHED;
            PG8_LDA(At, 1, 1); PG8_STAGE(PG8_SB(1, 0), b3, voffB); PG8_STAGE(PG8_SB(1, 1), b3 + hstepB, voffB); PG8_STAGE(PG8_SA(1, 0), a3, voffA);
            PG8_WAIT_V(8); PG8_WAIT_L(0); PG8_BAR; PG8_MMA(1, 0, At, B0); PG8_MMA(1, 1, At, B1); PG8_BAR; PG8_SCHED;
            } else {
            PG8_LDB(B0, 0, 0); PG8_SCHED; PG8_LDA(At, 0, 0); PG8_STAGE(PG8_SA(1, 1), a1 + hstepA, voffA);
            PG8_WAIT_L(8); PG8_BAR; PG8_WAIT_L(0); PG8_MMA(0, 0, At, B0); PG8_BAR; PG8_SCHED;
            PG8_LDB(B1, 0, 1); PG8_STAGE(PG8_SB(0, 0), b2, voffB);
            PG8_BAR; PG8_WAIT_L(0); PG8_MMA(0, 1, At, B1); PG8_BAR;
            PG8_LDA(At, 0, 1); PG8_STAGE(PG8_SA(0, 0), a2, voffA);
            PG8_BAR; PG8_WAIT_L(0); PG8_MMA(1, 0, At, B0); PG8_BAR; PG8_SCHED;
            PG8_STAGE(PG8_SB(0, 1), b2 + hstepB, voffB);
            PG8_WAIT_V(6); PG8_BAR; PG8_MMA(1, 1, At, B1); PG8_BAR;
            PG8_LDB(B0, 1, 0); PG8_SCHED; PG8_LDA(At, 1, 0); PG8_STAGE(PG8_SA(0, 1), a2 + hstepA, voffA);
            PG8_WAIT_L(8); PG8_BAR; PG8_WAIT_L(0); PG8_MMA(0, 0, At, B0); PG8_BAR; PG8_SCHED;
            PG8_LDB(B1, 1, 1); PG8_STAGE(PG8_SB(1, 0), b3, voffB);
            PG8_BAR; PG8_WAIT_L(0); PG8_MMA(0, 1, At, B1); PG8_BAR;
            PG8_LDA(At, 1, 1); PG8_STAGE(PG8_SA(1, 0), a3, voffA);
            PG8_BAR; PG8_WAIT_L(0); PG8_MMA(1, 0, At, B0); PG8_BAR; PG8_SCHED;
            PG8_STAGE(PG8_SB(1, 1), b3 + hstepB, voffB);
            PG8_WAIT_V(6); PG8_BAR; PG8_MMA(1, 1, At, B1); PG8_BAR;
            }
        }
        if constexpr (ALIGN_EPI) { if (wr == 0) PG8_BAR; }
        if constexpr (!Epi::AFTER_DRAIN) { E(acc, cur, wr, wc, fr, fq); S.done(cur); }
        if (!has_next) break;
#pragma unroll
        for (int a = 0; a < 2; ++a)
#pragma unroll
            for (int b = 0; b < 2; ++b)
#pragma unroll
                for (int m = 0; m < 4; ++m)
#pragma unroll
                    for (int n = 0; n < 2; ++n) acc[a][b][m][n] = (f32x4){0.f, 0.f, 0.f, 0.f};
        cur = nxt; cA = nA; cB = nB; ++ui;
        if constexpr (ALIGN_EPI) { if (wr == 1) PG8_BAR; }
    }
    PG8_WAIT_V(0);
    if constexpr (!ALIGN_EPI) { if (wr == 0) PG8_BAR; }
    PG8_BAR;
    if constexpr (Epi::AFTER_DRAIN) { E.fused(acc, cur, wr, wc, fr, fq, lds, wid, lane); S.done(cur); }
#undef PG8_SA
#undef PG8_SB
#undef PG8_STAGE
#undef PG8_LDA
#undef PG8_LDB
#undef PG8_MMA
#undef PG8_WAIT_V
#undef PG8_WAIT_L
#undef PG8_BAR
#undef PG8_SCHED
}
}

constexpr int NWAVES = 8, NTHREADS = NWAVES * 64;
constexpr int RING_BYTES = 131072;
constexpr int MISC_OFF = RING_BYTES + 320;
constexpr int LDS_BYTES = 147456;

struct Ptrs {
    const float* in[28];
    float* out;
    unsigned char* ws;
    int ph_lo, ph_hi;
};
typedef const __attribute__((address_space(4))) Ptrs* KP;

__device__ __forceinline__ void p0_item(const float* W, int N, bf16_t* WT, int ldk, int k0, int n0, int dst_row0, LAS float* scr, int lane) {
#pragma unroll 8
    for (int i = 0; i < 32; ++i) { const int kk = 2 * i + (lane >> 5); scr[kk * 33 + (lane & 31)] = W[(size_t)(k0 + kk) * N + n0 + (lane & 31)]; }
    asm volatile("s_waitcnt lgkmcnt(0)" ::: "memory");
    const int c = lane & 7;
#pragma unroll
    for (int j = 0; j < 4; ++j) { const int n = (lane >> 3) + 8 * j; const LAS float* s = scr + (8 * c) * 33 + n;
        u32x4 o; o.x = pk2(s[0 * 33], s[1 * 33]); o.y = pk2(s[2 * 33], s[3 * 33]); o.z = pk2(s[4 * 33], s[5 * 33]); o.w = pk2(s[6 * 33], s[7 * 33]);
        *(u32x4*)(WT + (size_t)(dst_row0 + n) * ldk + k0 + 8 * c) = o; }
    asm volatile("s_waitcnt lgkmcnt(0)" ::: "memory");
}
__device__ __forceinline__ void p0_mat(const float* W, int K, int N, bf16_t* WT, int mode  , int r, LAS float* scr, int lane) {
    const int nblk = N / 32, kb = r / nblk, nb = r % nblk, k0 = 64 * kb, n0 = 32 * nb;
    int dr = n0;
    if (mode == 1) dr = 256 * (n0 >> 7) + (n0 & 127);
    if (mode == 2) dr = 256 * (n0 >> 7) + 128 + (n0 & 127);
    p0_item(W, N, WT, K, k0, n0, dr, scr, lane);
}
__device__ __forceinline__ void phase_prep(KP P, LAS unsigned char* lds, int gw, int NGW, int wave, int lane) {
    LAS float* scr = (LAS float*)(lds + wave * 16384);
    unsigned char* ws = P->ws;
    constexpr int I_QKV = 16 * 48, I_O = 16 * 32, I_IN = 16 * 161, I_OUT = 32 * 32, I_POOL = 4 * 8, I_G = 16 * 88, I_DN = 44 * 32;
    constexpr int N_ITEMS = 2 * I_QKV + 2 * I_O + I_IN + I_OUT + 4 * I_POOL + 4 * (2 * I_G + I_DN);
    for (int it = gw; it < N_ITEMS; it += NGW) {
        int r = it;
        if (r < 2 * I_QKV) { const int j = r / I_QKV; r -= j * I_QKV; p0_mat(P->in[8] + (size_t)j * D * QKV_N, D, QKV_N, (bf16_t*)(ws + WS_WQKV) + (size_t)j * QKV_N * D, 0, r, scr, lane); continue; } r -= 2 * I_QKV;
        if (r < 2 * I_O) { const int j = r / I_O; r -= j * I_O; p0_mat(P->in[10] + (size_t)j * D * D, D, D, (bf16_t*)(ws + WS_WO) + (size_t)j * D * D, 0, r, scr, lane); continue; } r -= 2 * I_O;
        if (r < I_IN) { p0_mat(P->in[13], D, SSM_IN, (bf16_t*)(ws + WS_WIN), 0, r, scr, lane); continue; } r -= I_IN;
        if (r < I_OUT) { p0_mat(P->in[20], DI, D, (bf16_t*)(ws + WS_WOUT), 0, r, scr, lane); continue; } r -= I_OUT;
        if (r < 4 * I_POOL) { const int g = r / I_POOL; r -= g * I_POOL; p0_mat(P->in[21] + (size_t)g * 256 * 256, 256, 256, (bf16_t*)(ws + WS_WPOOL) + (size_t)g * 256 * 256, 0, r, scr, lane); continue; } r -= 4 * I_POOL;
        { const int per = 2 * I_G + I_DN, i = r / per; r -= i * per;
          if (r < I_G) { p0_mat(P->in[23] + (size_t)i * D * FF, D, FF, (bf16_t*)(ws + WS_WGU) + (size_t)i * GU_N * D, 1, r, scr, lane); continue; } r -= I_G;
          if (r < I_G) { p0_mat(P->in[24] + (size_t)i * D * FF, D, FF, (bf16_t*)(ws + WS_WGU) + (size_t)i * GU_N * D, 2, r, scr, lane); continue; } r -= I_G;
          p0_mat(P->in[25] + (size_t)i * FF * D, FF, D, (bf16_t*)(ws + WS_WD) + (size_t)i * D * FF, 0, r, scr, lane); }
    }
    { const int gt = gw * 64 + lane, NT = NGW * 64; u32x4* z = (u32x4*)((bf16_t*)(ws + WS_WIN) + (size_t)SSM_IN * D);
      for (int i = gt; i < (SSM_INP - SSM_IN) * D / 8; i += NT) z[i] = (u32x4){0u, 0u, 0u, 0u}; }
    { const int gt = gw * 64 + lane, NT = NGW * 64; bf16_t* XB = (bf16_t*)(ws + WS_XB);
      for (int i = gt; i < M * D / 8; i += NT) { const int row = i >> 7, c = (i & 127) * 8;
          const float* src = (row < MP ? P->in[0] + (size_t)row * D : P->in[1] + (size_t)(row - MP) * D) + c;
          const f32x4 a = *(const f32x4*)src, b = *(const f32x4*)(src + 4);
          u32x4 w; w.x = pk2(a[0], a[1]); w.y = pk2(a[2], a[3]); w.z = pk2(b[0], b[1]); w.w = pk2(b[2], b[3]);
          *(u32x4*)(XB + (size_t)row * D + c) = w; } }
}

__device__ __forceinline__ void phase_ln(const float* Z, const float* g, const float* b, float* XF, bf16_t* XB, int gw, int NGW, int lane) {
    f32x4 gv[4], bv[4];
#pragma unroll
    for (int j = 0; j < 4; ++j) { gv[j] = *(const f32x4*)(g + 256 * j + 4 * lane); bv[j] = *(const f32x4*)(b + 256 * j + 4 * lane); }
    for (int row = gw; row < M; row += NGW) {
        const float* zr = Z + (size_t)row * D + 4 * lane;
        f32x4 v[4]; float s = 0.f;
#pragma unroll
        for (int j = 0; j < 4; ++j) { v[j] = *(const f32x4*)(zr + 256 * j); s += (v[j][0] + v[j][1]) + (v[j][2] + v[j][3]); }
        const float mean = wave_sum(s) * (1.f / D); float s2 = 0.f;
#pragma unroll
        for (int j = 0; j < 4; ++j) { v[j] = v[j] - mean; s2 += (v[j][0] * v[j][0] + v[j][1] * v[j][1]) + (v[j][2] * v[j][2] + v[j][3] * v[j][3]); }
        const float rstd = 1.0f / sqrtf(wave_sum(s2) * (1.f / D) + LN_EPS);
        float* xo = XF + (size_t)row * D + 4 * lane; bf16_t* bo = XB + (size_t)row * D + 4 * lane;
#pragma unroll
        for (int j = 0; j < 4; ++j) { const f32x4 o = v[j] * rstd * gv[j] + bv[j]; *(f32x4*)(xo + 256 * j) = o;
            u32x2 w; w.x = pk2(o[0], o[1]); w.y = pk2(o[2], o[3]); *(u32x2*)(bo + 256 * j) = w; }
    }
}

__device__ __forceinline__ int t5_bucket(int n) {
    if (n < 16) return n;
    const int l = 16 + (int)(__log2f((float)n * (1.0f / 16.0f)) * (16.0f / 3.0f));
    return l < 31 ? l : 31;
}
__device__ __forceinline__ f32x4 attn_qk_slot(const bf16_t* QKV, const float* ck, const float* rel_bias, const LAS float* qs, int row, int kv, bool smp, int pos, int sb, int si, int w) {
    bool valid = true; const bf16_t* kb = nullptr; const float* kf = nullptr;
    if (!smp) { valid = (pos - 127 + w) >= 0; kb = QKV + (size_t)(valid ? row - 127 + w : row) * QKV_N + KCOL + kv * HD; }
    else { const int j = si + 1 + w; if (j < WIN) kf = ck + ((size_t)(sb * WIN + j) * NKV + kv) * HD; else kb = QKV + (size_t)(MP + sb * SL + (j - WIN)) * QKV_N + KCOL + kv * HD; }
    float a0 = 0.f, a1 = 0.f, a2 = 0.f, a3 = 0.f;
#pragma unroll 1
    for (int c = 0; c < 8; ++c) {
        float k[8];
        if (kf) { const f32x4 x = *(const f32x4*)(kf + 8 * c), y = *(const f32x4*)(kf + 8 * c + 4); k[0] = x[0]; k[1] = x[1]; k[2] = x[2]; k[3] = x[3]; k[4] = y[0]; k[5] = y[1]; k[6] = y[2]; k[7] = y[3]; }
        else { const u32x4 x = *(const u32x4*)(kb + 8 * c); k[0] = bflo(x.x); k[1] = bfhi(x.x); k[2] = bflo(x.y); k[3] = bfhi(x.y); k[4] = bflo(x.z); k[5] = bfhi(x.z); k[6] = bflo(x.w); k[7] = bfhi(x.w); }
#pragma unroll
        for (int e = 0; e < 8; ++e) { a0 += qs[0 * 64 + 8 * c + e] * k[e]; a1 += qs[1 * 64 + 8 * c + e] * k[e]; a2 += qs[2 * 64 + 8 * c + e] * k[e]; a3 += qs[3 * 64 + 8 * c + e] * k[e]; }
    }
    const int bk = t5_bucket(127 - w);
    const f32x4 rb = *(const f32x4*)(rel_bias + bk * NHQ + kv * 4);
    const float ninf = -INFINITY;
    return (f32x4){valid ? a0 + rb[0] : ninf, valid ? a1 + rb[1] : ninf, valid ? a2 + rb[2] : ninf, valid ? a3 + rb[3] : ninf};
}
__device__ __forceinline__ void phase_attn(const bf16_t* QKV, bf16_t* O, const float* ck, const float* cv, const float* rel_bias, const float* sinks,
                                           float* kS, float* vS, LAS unsigned char* lds, int gw, int NGW, int wave, int lane) {
    LAS float* qs = (LAS float*)(lds + wave * 4096);
    LAS float* ps = qs + 256;
    for (int u = gw; u < M * NKV; u += NGW) {
        const int row = u >> 2, kv = u & 3;
        const bool smp = row >= MP;
        const int pos = row & (PL - 1);
        const int rs = row - MP, sb = rs >> 3, si = rs & 7;
        {
            const int g = lane >> 4, d4 = (lane & 15) * 4;
            const u32x2 w = *(const u32x2*)(QKV + (size_t)row * QKV_N + (kv * 4 + g) * HD + d4);
            qs[g * 64 + d4 + 0] = bflo(w.x) * 0.125f; qs[g * 64 + d4 + 1] = bfhi(w.x) * 0.125f; qs[g * 64 + d4 + 2] = bflo(w.y) * 0.125f; qs[g * 64 + d4 + 3] = bfhi(w.y) * 0.125f;
        }
        asm volatile("s_waitcnt lgkmcnt(0)" ::: "memory");
        f32x4 s0 = attn_qk_slot(QKV, ck, rel_bias, qs, row, kv, smp, pos, sb, si, lane);
        f32x4 s1 = attn_qk_slot(QKV, ck, rel_bias, qs, row, kv, smp, pos, sb, si, lane + 64);
        float s[2][4];
        s[0][0] = s0[0]; s[0][1] = s0[1]; s[0][2] = s0[2]; s[0][3] = s0[3]; s[1][0] = s1[0]; s[1][1] = s1[1]; s[1][2] = s1[2]; s[1][3] = s1[3];
#pragma unroll
        for (int g = 0; g < 4; ++g) {
            const float sink = sinks[kv * 4 + g];
            const float mx = fmaxf(wave_max(fmaxf(s[0][g], s[1][g])), sink);
            const float p0 = __expf(s[0][g] - mx), p1 = __expf(s[1][g] - mx);
            const float den = wave_sum(p0 + p1) + __expf(sink - mx);
            const float inv = 1.0f / den;
            ps[lane * 4 + g] = p0 * inv; ps[(lane + 64) * 4 + g] = p1 * inv;
        }
        asm volatile("s_waitcnt lgkmcnt(0)" ::: "memory");
        float o0 = 0.f, o1 = 0.f, o2 = 0.f, o3 = 0.f;
        const int w0 = smp ? 0 : (pos >= 127 ? 0 : 127 - pos);
        for (int w = w0; w < WIN; ++w) {
            float v;
            if (!smp) v = bf1(QKV[(size_t)(row - 127 + w) * QKV_N + VCOL + kv * HD + lane]);
            else { const int j = si + 1 + w; v = (j < WIN) ? cv[((size_t)(sb * WIN + j) * NKV + kv) * HD + lane] : bf1(QKV[(size_t)(MP + sb * SL + (j - WIN)) * QKV_N + VCOL + kv * HD + lane]); }
            const f32x4 p = *(const LAS f32x4*)(ps + w * 4);
            o0 += p[0] * v; o1 += p[1] * v; o2 += p[2] * v; o3 += p[3] * v;
        }
        bf16_t* op = O + (size_t)row * D + kv * 4 * HD + lane;
        op[0] = (bf16_t)f2bf(o0); op[HD] = (bf16_t)f2bf(o1); op[2 * HD] = (bf16_t)f2bf(o2); op[3 * HD] = (bf16_t)f2bf(o3);
        asm volatile("s_waitcnt lgkmcnt(0)" ::: "memory");
    }
    { const int gt = gw * 64 + lane, NT = NGW * 64;
      for (int i = gt; i < SB * 120 * 64; i += NT) { const int c4 = (i & 63) * 4, r = (i >> 6) % 120, b = (i >> 6) / 120;
          const size_t src = ((size_t)b * WIN + r + 8) * 256 + c4, dst = ((size_t)b * WIN + r) * 256 + c4;
          *(f32x4*)(kS + dst) = *(const f32x4*)(ck + src); *(f32x4*)(vS + dst) = *(const f32x4*)(cv + src); } }
}

constexpr int SSD_CH = 64;
__device__ __forceinline__ void phase_ssd(KP P, LAS unsigned char* lds, int tid) {
    const bf16_t* ZX = (const bf16_t*)(P->ws + WS_ZX); bf16_t* Y = (bf16_t*)(P->ws + WS_Y);
    const float* conv_w = P->in[14]; const float* conv_b = P->in[15]; const float* dt_bias = P->in[16]; const float* a_log = P->in[17]; const float* dsk = P->in[18];
    const float* st_conv = P->in[4]; const float* st_ssm = P->in[5];
    LAS float* xs = (LAS float*)lds;
    LAS float* Bs = xs + SSD_CH * 64;
    LAS float* Cs = Bs + SSD_CH * 128;
    LAS float* ys = Cs + SSD_CH * 128;
    LAS float* dts = ys + SSD_CH * 64;
    LAS float* dAs = dts + SSD_CH;
    const int p = tid >> 3, nb = tid & 7;
    for (int u = blockIdx.x; u < PB * SH + SB * SH; u += gridDim.x) {
        const bool smp = u >= PB * SH;
        const int uu = smp ? u - PB * SH : u;
        const int b = uu >> 5, h = uu & 31, g = h >> 3;
        const int row0 = smp ? MP + b * SL : b * PL, T = smp ? SL : PL;
        const float a = -__expf(a_log[h]), dtb = dt_bias[h], Dh = dsk[h];
        float hr[16];
        const size_t hoff = (((size_t)b * SH + h) * SP + p) * SN + nb * 16;
        if (smp) {
#pragma unroll
            for (int i = 0; i < 4; ++i) { const f32x4 v = *(const f32x4*)(st_ssm + hoff + 4 * i); hr[4 * i] = v[0]; hr[4 * i + 1] = v[1]; hr[4 * i + 2] = v[2]; hr[4 * i + 3] = v[3]; }
        } else {
#pragma unroll
            for (int i = 0; i < 16; ++i) hr[i] = 0.f;
        }
        for (int t0 = 0; t0 < T; t0 += SSD_CH) {
            const int Tc = (T - t0) < SSD_CH ? (T - t0) : SSD_CH;
            for (int idx = tid; idx < Tc * 320; idx += NTHREADS) {
                const int t = idx / 320, ch = idx - t * 320;
                const int cc = ch < 64 ? h * 64 + ch : (ch < 192 ? DI + g * 128 + (ch - 64) : DI + 512 + g * 128 + (ch - 192));
                float v = conv_b[cc];
#pragma unroll
                for (int j = 0; j < 4; ++j) {
                    const int tt = t0 + t - 3 + j;
                    float r;
                    if (tt >= 0) r = bf1(ZX[(size_t)(row0 + tt) * SSM_INP + XBC_COL + cc]);
                    else r = smp ? st_conv[((size_t)b * 3 + (3 + tt)) * CONV_D + cc] : 0.f;
                    v += conv_w[j * CONV_D + cc] * r;
                }
                v = silu_f(v);
                if (ch < 64) xs[t * 64 + ch] = v; else if (ch < 192) Bs[t * 128 + (ch - 64)] = v; else Cs[t * 128 + (ch - 192)] = v;
            }
            if (tid < Tc) {
                const float raw = bf1(ZX[(size_t)(row0 + t0 + tid) * SSM_INP + DT_COL + h]) + dtb;
                const float dtv = raw > 20.f ? raw : log1pf(__expf(raw));
                dts[tid] = dtv; dAs[tid] = __expf(dtv * a);
            }
            __syncthreads();
            for (int t = 0; t < Tc; ++t) {
                const float dA = dAs[t], xv = xs[t * 64 + p], xdt = xv * dts[t];
                float acc = 0.f;
#pragma unroll
                for (int i = 0; i < 4; ++i) {
                    const f32x4 Bv = *(const LAS f32x4*)(Bs + t * 128 + nb * 16 + 4 * i), Cv = *(const LAS f32x4*)(Cs + t * 128 + nb * 16 + 4 * i);
#pragma unroll
                    for (int e = 0; e < 4; ++e) { hr[4 * i + e] = hr[4 * i + e] * dA + xdt * Bv[e]; acc += Cv[e] * hr[4 * i + e]; }
                }
                acc += __shfl_xor(acc, 1); acc += __shfl_xor(acc, 2); acc += __shfl_xor(acc, 4);
                if (nb == 0) ys[t * 64 + p] = acc + Dh * xv;
            }
            __syncthreads();
            for (int idx = tid; idx < Tc * 32; idx += NTHREADS) { const int t = idx >> 5, c2 = (idx & 31) * 2;
                *(unsigned*)(Y + (size_t)(row0 + t0 + t) * DI + h * 64 + c2) = pk2(ys[t * 64 + c2], ys[t * 64 + c2 + 1]); }
            __syncthreads();
        }
        float* ho = P->out + (smp ? O_SS : O_SP) + hoff;
#pragma unroll
        for (int i = 0; i < 4; ++i) *(f32x4*)(ho + 4 * i) = (f32x4){hr[4 * i], hr[4 * i + 1], hr[4 * i + 2], hr[4 * i + 3]};
    }
}

__device__ __forceinline__ void phase_gnorm(KP P, int gw, int NGW, int lane) {
    const bf16_t* ZX = (const bf16_t*)(P->ws + WS_ZX); bf16_t* Y = (bf16_t*)(P->ws + WS_Y); const float* nw = P->in[19];
    for (int u = gw; u < M * 4; u += NGW) {
        const int row = u >> 2, c = (u & 3) * 512 + lane * 8;
        const u32x4 yw = *(const u32x4*)(Y + (size_t)row * DI + c), zw = *(const u32x4*)(ZX + (size_t)row * SSM_INP + c);
        float v[8];
        v[0] = bflo(yw.x) * silu_f(bflo(zw.x)); v[1] = bfhi(yw.x) * silu_f(bfhi(zw.x)); v[2] = bflo(yw.y) * silu_f(bflo(zw.y)); v[3] = bfhi(yw.y) * silu_f(bfhi(zw.y));
        v[4] = bflo(yw.z) * silu_f(bflo(zw.z)); v[5] = bfhi(yw.z) * silu_f(bfhi(zw.z)); v[6] = bflo(yw.w) * silu_f(bflo(zw.w)); v[7] = bfhi(yw.w) * silu_f(bfhi(zw.w));
        float ss = 0.f;
#pragma unroll
        for (int e = 0; e < 8; ++e) ss += v[e] * v[e];
        const float r = 1.0f / sqrtf(wave_sum(ss) * (1.0f / 512.0f) + RMS_EPS);
        const f32x4 w0 = *(const f32x4*)(nw + c), w1 = *(const f32x4*)(nw + c + 4);
        u32x4 o; o.x = pk2(v[0] * r * w0[0], v[1] * r * w0[1]); o.y = pk2(v[2] * r * w0[2], v[3] * r * w0[3]); o.z = pk2(v[4] * r * w1[0], v[5] * r * w1[1]); o.w = pk2(v[6] * r * w1[2], v[7] * r * w1[3]);
        *(u32x4*)(Y + (size_t)row * DI + c) = o;
    }
}

__device__ __forceinline__ void phase_pooldiff(KP P, int gw, int NGW, int lane) {
    const float* XF = P->out; const float* spool = P->in[6]; bf16_t* DF = (bf16_t*)(P->ws + WS_DIFF);
    const int gt = gw * 64 + lane, NT = NGW * 64;
    for (int i = gt; i < M * 256; i += NT) {
        const int row = i >> 8, c4 = (i & 255) * 4, w = 2 << (c4 >> 8);
        f32x4 s = (f32x4){0.f, 0.f, 0.f, 0.f}; float cnt;
        const f32x4 x = *(const f32x4*)(XF + (size_t)row * D + c4);
        if (row < MP) { const int pos = row & (PL - 1); const int n = (pos + 1) < w ? (pos + 1) : w; cnt = (float)n;
            for (int j = 0; j < n; ++j) s += *(const f32x4*)(XF + (size_t)(row - j) * D + c4); }
        else { const int rs = row - MP, b = rs >> 3, si = rs & 7; cnt = (float)w;
            for (int j = 0; j < w; ++j) { const int r = 15 + si - j;
                s += (r >= 15) ? *(const f32x4*)(XF + (size_t)(MP + b * SL + r - 15) * D + c4) : *(const f32x4*)(spool + ((size_t)b * 15 + r) * D + c4); } }
        const f32x4 d = s / cnt - x;
        u32x2 o; o.x = pk2(d[0], d[1]); o.y = pk2(d[2], d[3]);
        *(u32x2*)(DF + (size_t)row * D + c4) = o;
    }
    for (int i = gt; i < PB * 15 * 256; i += NT) { const int c4 = (i & 255) * 4, r = (i >> 8) % 15, b = (i >> 8) / 15;
        *(f32x4*)(P->out + O_PP + ((size_t)b * 15 + r) * D + c4) = *(const f32x4*)(XF + (size_t)(b * PL + PL - 15 + r) * D + c4); }
    for (int i = gt; i < SB * 15 * 256; i += NT) { const int c4 = (i & 255) * 4, r = (i >> 8) % 15, b = (i >> 8) / 15;
        *(f32x4*)(P->out + O_PS + ((size_t)b * 15 + r) * D + c4) = (r < 7) ? *(const f32x4*)(spool + ((size_t)b * 15 + 8 + r) * D + c4) : *(const f32x4*)(XF + (size_t)(MP + b * SL + r - 7) * D + c4); }
}

typedef GAS unsigned gu32;
#define XB_TMO      128
#define XB_XCNT(j)  (256  + 64 * (j))
#define XB_XSUB(j)  (1280 + 64 * (j))
#define XB_XGEN(j)  (2304 + 64 * (j))
#define XB_TOP      3328
#define XB_TOPGEN   3392
#define XCD_BAR_WORDS 3456
#define XB_SPIN_CAP (1u << 18)
__device__ __forceinline__ unsigned xb_ld(unsigned* p)              { return __hip_atomic_load(p, __ATOMIC_RELAXED, __HIP_MEMORY_SCOPE_AGENT); }
__device__ __forceinline__ unsigned xb_add(unsigned* p, unsigned v) { return __hip_atomic_fetch_add(p, v, __ATOMIC_RELAXED, __HIP_MEMORY_SCOPE_AGENT); }
__device__ __forceinline__ unsigned xb_xcc_id() { return (unsigned)__builtin_amdgcn_s_getreg((3 << 11) | 20) & 0xFu; }
#define XB_SPIN(cond, bar) do { unsigned _sp = 0; while (cond) { __builtin_amdgcn_s_sleep(1); \
    if ((++_sp & 255u) == 0u) { if (xb_ld(&(bar)[XB_TMO])) break; if (_sp > XB_SPIN_CAP) { atomicAdd(&(bar)[XB_TMO], 1u); break; } } } } while (0)
struct XcdBarrier { unsigned* bar; unsigned x; volatile LAS unsigned* st; };
__device__ __forceinline__ XcdBarrier xcd_barrier_post(unsigned* bar, volatile LAS unsigned* st) {
    XcdBarrier b; b.bar = bar; b.x = xb_xcc_id(); b.st = st;
    if (threadIdx.x == 0) (void)xb_add(&bar[XB_XCNT(b.x)], 1u);
    return b;
}
__device__ __forceinline__ void xcd_barrier_complete(unsigned* bar, unsigned x, unsigned& nloc, unsigned& nx) {
    const unsigned G = gridDim.x * gridDim.y * gridDim.z;
    unsigned sum, cnt, mine, sp = 0u;
    for (;;) {
        sum = 0u; cnt = 0u; mine = 0u;
#pragma unroll
        for (unsigned j = 0; j < 16; ++j) { const unsigned c = xb_ld(&bar[XB_XCNT(j)]); sum += c; cnt += (c > 0u) ? 1u : 0u; mine = (j == x) ? c : mine; }
        if (sum == G) break;
        __builtin_amdgcn_s_sleep(1);
        if ((++sp & 255u) == 0u) { if (xb_ld(&bar[XB_TMO])) break; if (sp > XB_SPIN_CAP) { atomicAdd(&bar[XB_TMO], 1u); break; } }
    }
    nloc = mine > 0u ? mine : 1u; nx = cnt > 0u ? cnt : 1u;
}
__device__ __forceinline__ void xcd_barrier(const XcdBarrier& b) {
    asm volatile("s_waitcnt vmcnt(0)" ::: "memory");
    __syncthreads();
    if (threadIdx.x == 0) {
        unsigned* bar = b.bar;
        __builtin_amdgcn_s_waitcnt(0);
        unsigned nloc = b.st[0], nx = b.st[1];
        if (nloc == 0u) { xcd_barrier_complete(bar, b.x, nloc, nx); b.st[0] = nloc; b.st[1] = nx; }
        const unsigned old = xb_add(&bar[XB_XSUB(b.x)], 1u);
        const unsigned gen = old / nloc;
        if (old + 1u == (gen + 1u) * nloc) {
            __builtin_amdgcn_fence(__ATOMIC_RELEASE, "agent");
            asm volatile("s_waitcnt vmcnt(0)" ::: "memory");
            const unsigned og = xb_add(&bar[XB_TOP], 1u);
            const unsigned tg = og / nx;
            if (og + 1u == (tg + 1u) * nx) xb_add(&bar[XB_TOPGEN], 1u);
            else XB_SPIN(xb_ld(&bar[XB_TOPGEN]) == tg, bar);
            __builtin_amdgcn_fence(__ATOMIC_ACQUIRE, "agent");
            xb_add(&bar[XB_XGEN(b.x)], 1u);
            asm volatile("s_waitcnt vmcnt(0)" ::: "memory");
        } else {
            XB_SPIN(xb_ld(&bar[XB_XGEN(b.x)]) == gen, bar);
            __builtin_amdgcn_fence(__ATOMIC_ACQUIRE, "agent");
            asm volatile("s_waitcnt vmcnt(0)" ::: "memory");
        }
    }
    __syncthreads();
}

#ifndef MK_PER_PHASE
#define MK_PER_PHASE 0
#endif
constexpr int N_PHASES = 29;
enum { OP_PREP = 0, OP_GEMM_SIDE, OP_ATTN, OP_GEMM_RES, OP_LN, OP_GEMM_UP, OP_SSD, OP_GNORM, OP_DIFF };

__global__ void __launch_bounds__(NTHREADS, 2) fwd_kernel(Ptrs Parg) {
    extern __shared__ __attribute__((aligned(16))) unsigned char lds_raw[];
    LAS unsigned char* lds = (LAS unsigned char*)lds_raw;
    const int ph_lo = Parg.ph_lo, ph_hi = Parg.ph_hi;
    {
        const int tid0 = threadIdx.x;
        for (int u = tid0; u < (LDS_BYTES - RING_BYTES) / 4; u += NTHREADS) ((LAS unsigned*)(lds + RING_BYTES))[u] = 0u;
        __syncthreads();
        if (ph_hi - ph_lo > 1) { if (tid0 == 0) (void)xb_add(&((unsigned*)(Parg.ws + WS_CTL) + 4096)[XB_XCNT(xb_xcc_id())], 1u); }
    }
    for (int ph = ph_lo; ph < ph_hi; ++ph) {
        int tid = threadIdx.x; asm volatile("" : "+v"(tid));
        KP P = (KP)__builtin_amdgcn_kernarg_segment_ptr(); asm volatile("" : "+s"(P));
        int bx = blockIdx.x; asm volatile("" : "+s"(bx));
        const int lane = tid & 63, wave = __builtin_amdgcn_readfirstlane(tid >> 6);
        const int G = gridDim.x;
        const int vcu = (G % 8 == 0) ? (bx % 8) * (G / 8) + bx / 8 : bx;
        const int gw = vcu * NWAVES + wave, NGW = G * NWAVES;
        unsigned char* ws = P->ws;
        bf16_t* XB = (bf16_t*)(ws + WS_XB);
        float* Z = (float*)(ws + WS_Z);
        float* XF = P->out;
        int op = OP_PREP, L = 0, t = 0;
        if (ph > 0) {
            const int q = ph - 1; int sub;
            if (q < 7) { L = 0; sub = q; } else if (q < 15) { L = 1; sub = q - 7; } else if (q < 21) { L = 2; sub = q - 15; } else { L = 3; sub = q - 21; }
            const int kind = L == 1 ? 1 : (L == 2 ? 2 : 0);
            const int npre = kind == 0 ? 2 : (kind == 1 ? 3 : 1);
            if (sub < npre) { op = kind == 0 ? (sub == 0 ? OP_GEMM_SIDE : OP_ATTN) : (kind == 1 ? (sub == 0 ? OP_GEMM_SIDE : (sub == 1 ? OP_SSD : OP_GNORM)) : OP_DIFF); }
            else { t = sub - npre; op = (t == 0 || t == 3) ? OP_GEMM_RES : ((t == 1 || t == 4) ? OP_LN : OP_GEMM_UP); }
        }
        const int kind = L == 1 ? 1 : (L == 2 ? 2 : 0);
        const int j = L / 3;
#ifndef ONLY_OP
#define ONLY_OP -1
#endif
#define EN(o) (ONLY_OP < 0 || ONLY_OP == (o))
        if (EN(OP_PREP) && op == OP_PREP) {
            phase_prep(P, lds, gw, NGW, wave, lane);
        } else if (EN(OP_GEMM_SIDE) && op == OP_GEMM_SIDE) {
            pg8::Gemm g; pg8::EpiBf16Side E;
            g.A = XB; g.M = M; g.K = D; g.lda = D; g.ldb = D; g.a_pn_bytes = 0;
            E.out = P->out; E.j = j;
            if (kind == 0) { g.Bt = (const bf16_t*)(ws + WS_WQKV) + (size_t)j * QKV_N * D; g.N = QKV_N; E.O = (bf16_t*)(ws + WS_QKV); E.bias = P->in[9] + j * QKV_N; E.mode = 0; }
            else { g.Bt = (const bf16_t*)(ws + WS_WIN); g.N = SSM_INP; E.O = (bf16_t*)(ws + WS_ZX); E.bias = nullptr; E.mode = 1; }
            pg8::StaticOrder S; S.init(M, g.N, G, bx);
            pg8::gemm_phase<pg8::EpiBf16Side, pg8::StaticOrder, true, true>(lds, g, S, E, tid);
        } else if (EN(OP_ATTN) && op == OP_ATTN) {
            phase_attn((const bf16_t*)(ws + WS_QKV), (bf16_t*)(ws + WS_O), P->in[2] + (size_t)j * SB * WIN * 256, P->in[3] + (size_t)j * SB * WIN * 256, P->in[7], P->in[12] + j * NHQ,
                       P->out + O_KS + (size_t)j * SB * WIN * 256, P->out + O_VS + (size_t)j * SB * WIN * 256, lds, gw, NGW, wave, lane);
        } else if (EN(OP_GEMM_RES) && op == OP_GEMM_RES) {
            pg8::Gemm g; pg8::EpiRes E;
            g.M = M; g.N = D; g.a_pn_bytes = 0;
            E.Z = Z; E.bias = nullptr; E.scale = nullptr;
            if (L == 0 && t == 0) { E.baseP = P->in[0]; E.baseS = P->in[1]; } else { E.baseP = XF; E.baseS = XF + (size_t)MP * D; }
            if (t == 3) { g.A = (const bf16_t*)(ws + WS_H); g.lda = FF; g.Bt = (const bf16_t*)(ws + WS_WD) + (size_t)L * D * FF; g.ldb = FF; g.K = FF; }
            else if (kind == 0) { g.A = (const bf16_t*)(ws + WS_O); g.lda = D; g.Bt = (const bf16_t*)(ws + WS_WO) + (size_t)j * D * D; g.ldb = D; g.K = D; E.bias = P->in[11] + j * D; }
            else if (kind == 1) { g.A = (const bf16_t*)(ws + WS_Y); g.lda = DI; g.Bt = (const bf16_t*)(ws + WS_WOUT); g.ldb = DI; g.K = DI; }
            else { g.A = (const bf16_t*)(ws + WS_DIFF); g.lda = D; g.Bt = (const bf16_t*)(ws + WS_WPOOL); g.ldb = 256; g.K = 256; g.a_pn_bytes = 512; E.scale = P->in[22]; }
            pg8::StaticOrder S; S.init(M, D, G, bx);
            pg8::gemm_phase<pg8::EpiRes, pg8::StaticOrder, true, true>(lds, g, S, E, tid);
        } else if (EN(OP_LN) && op == OP_LN) {
            const int which = (t == 1) ? 0 : 1;
            phase_ln(Z, P->in[26] + (size_t)(L * 2 + which) * D, P->in[27] + (size_t)(L * 2 + which) * D, XF, XB, gw, NGW, lane);
        } else if (EN(OP_GEMM_UP) && op == OP_GEMM_UP) {
            pg8::Gemm g; g.A = XB; g.Bt = (const bf16_t*)(ws + WS_WGU) + (size_t)L * GU_N * D; g.M = M; g.N = GU_N; g.K = D; g.lda = D; g.ldb = D; g.a_pn_bytes = 0;
            pg8::EpiSwiGLU E; E.O = (bf16_t*)(ws + WS_H); E.ldc = FF;
            pg8::StaticOrder S; S.init(M, GU_N, G, bx);
            pg8::gemm_phase<pg8::EpiSwiGLU, pg8::StaticOrder, true, true>(lds, g, S, E, tid);
        } else if (EN(OP_SSD) && op == OP_SSD) {
            phase_ssd(P, lds, tid);
        } else if (EN(OP_GNORM) && op == OP_GNORM) {
            phase_gnorm(P, gw, NGW, lane);
        } else if (EN(OP_DIFF) && op == OP_DIFF) {
            phase_pooldiff(P, gw, NGW, lane);
        }
        if (ph + 1 < ph_hi) { XcdBarrier bar; bar.bar = (unsigned*)(P->ws + WS_CTL) + 4096; bar.x = xb_xcc_id(); bar.st = (volatile LAS unsigned*)(lds + MISC_OFF) + 8; xcd_barrier(bar); }
    }
}

extern "C" void kernel_launch(void* const* d_in, const int* in_sizes, int n_in, void* d_out, int out_size, void* d_ws, size_t ws_size, hipStream_t stream) {
    static int grid = 0;
    if (grid == 0) {
        if (n_in != 28 || out_size != (int)O_END || ws_size < WS_END) { fprintf(stderr, "kernel_launch: unexpected shapes (n_in %d, out %d, ws %zu)\n", n_in, out_size, ws_size); grid = -1; return; }
        int dev = 0, cus = 0;
        if (hipGetDevice(&dev) != hipSuccess || hipDeviceGetAttribute(&cus, hipDeviceAttributeMultiprocessorCount, dev) != hipSuccess) { grid = -1; return; }
        if (hipFuncSetAttribute((const void*)fwd_kernel, hipFuncAttributeMaxDynamicSharedMemorySize, LDS_BYTES) != hipSuccess) { fprintf(stderr, "kernel_launch: hipFuncSetAttribute failed\n"); grid = -1; return; }
        (void)hipGetLastError();
        grid = cus;
    }
    if (grid < 0) return;
    (void)hipMemsetAsync((char*)d_ws + WS_CTL, 0, CTL_ZERO_BYTES, stream);
    Ptrs a{};
    for (int i = 0; i < 28; ++i) a.in[i] = (const float*)d_in[i];
    a.out = (float*)d_out; a.ws = (unsigned char*)d_ws;
#if MK_PER_PHASE
    for (int ph = 0; ph < N_PHASES; ++ph) { a.ph_lo = ph; a.ph_hi = ph + 1; hipLaunchKernelGGL(fwd_kernel, dim3(grid), dim3(NTHREADS), LDS_BYTES, stream, a); }
#else
    a.ph_lo = 0; a.ph_hi = N_PHASES;
    hipLaunchKernelGGL(fwd_kernel, dim3(grid), dim3(NTHREADS), LDS_BYTES, stream, a);
#endif
}
```

```cpp
#include <hip/hip_runtime.h>
#include <cstdio>
#include <cstdint>

#define LAS __attribute__((address_space(3)))
#define GAS __attribute__((address_space(1)))
typedef unsigned short bf16_t;
typedef short bf16x8 __attribute__((ext_vector_type(8)));
typedef float f32x4 __attribute__((ext_vector_type(4)));
typedef float f32x2 __attribute__((ext_vector_type(2)));
typedef unsigned u32x4 __attribute__((ext_vector_type(4)));
typedef unsigned u32x2 __attribute__((ext_vector_type(2)));

constexpr int D = 1024;
constexpr int PB = 8, PL = 2048, MP = PB * PL;
constexpr int SB = 128, SL = 8, MS = SB * SL;
constexpr int M = MP + MS;
constexpr int NKV = 4, HD = 64, NHQ = 16, WIN = 128;
constexpr int QKV_N = 1536, KCOL = 1024, VCOL = 1280;
constexpr int FF = 2816, GU_N = 2 * FF;
constexpr int DI = 2048, CONV_D = 3072, SSM_IN = 5152, SSM_INP = 5376, SH = 32, SP = 64, SN = 128;
constexpr int XBC_COL = 2048, DT_COL = 5120;
constexpr int DEPTH = 4;
constexpr float LN_EPS = 1e-5f, RMS_EPS = 1e-5f;
constexpr float ALPHA = 1.6817928305074290f;

constexpr size_t O_Y = 0;
constexpr size_t O_KP = (size_t)M * D;
constexpr size_t O_VP = O_KP + (size_t)2 * PB * WIN * 256;
constexpr size_t O_CP = O_VP + (size_t)2 * PB * WIN * 256;
constexpr size_t O_SP = O_CP + (size_t)PB * 3 * CONV_D;
constexpr size_t O_PP = O_SP + (size_t)PB * SH * SP * SN;
constexpr size_t O_KS = O_PP + (size_t)PB * 15 * D;
constexpr size_t O_VS = O_KS + (size_t)2 * SB * WIN * 256;
constexpr size_t O_CS = O_VS + (size_t)2 * SB * WIN * 256;
constexpr size_t O_SS = O_CS + (size_t)SB * 3 * CONV_D;
constexpr size_t O_PS = O_SS + (size_t)SB * SH * SP * SN;
constexpr size_t O_END = O_PS + (size_t)SB * 15 * D;
static_assert(O_END == 74645504, "output size");

constexpr size_t MiB = 1u << 20;
constexpr size_t WS_CTL = 0, CTL_ZERO_BYTES = 1 * MiB;
constexpr size_t WS_WQKV = 1 * MiB;
constexpr size_t WS_WO = WS_WQKV + 6 * MiB;
constexpr size_t WS_WIN = WS_WO + 4 * MiB;
constexpr size_t WS_WOUT = WS_WIN + 11 * MiB;
constexpr size_t WS_WPOOL = WS_WOUT + 4 * MiB;
constexpr size_t WS_WGU = WS_WPOOL + 1 * MiB;
constexpr size_t WS_WD = WS_WGU + 44 * MiB;
constexpr size_t WS_XB = WS_WD + 22 * MiB;
constexpr size_t WS_Z = WS_XB + 34 * MiB;
constexpr size_t WS_BIG = WS_Z + 68 * MiB;
constexpr size_t WS_QKV = WS_BIG;
constexpr size_t WS_O = WS_BIG + 52 * MiB;
constexpr size_t WS_H = WS_BIG;
constexpr size_t WS_ZX = WS_BIG;
constexpr size_t WS_Y = WS_BIG + 180 * MiB;
constexpr size_t WS_DIFF = WS_BIG;
constexpr size_t WS_END = WS_BIG + 250 * MiB;
static_assert(WS_END <= 512 * MiB, "d_ws map");

__device__ __forceinline__ unsigned f2bf(float f) { unsigned u = __builtin_bit_cast(unsigned, f); return (u + 0x7fffu + ((u >> 16) & 1u)) >> 16; }
__device__ __forceinline__ unsigned pk2(float lo, float hi) { return f2bf(lo) | (f2bf(hi) << 16); }
__device__ __forceinline__ float bflo(unsigned w) { return __builtin_bit_cast(float, w << 16); }
__device__ __forceinline__ float bfhi(unsigned w) { return __builtin_bit_cast(float, w & 0xffff0000u); }
__device__ __forceinline__ float bf1(bf16_t h) { return __builtin_bit_cast(float, (unsigned)h << 16); }
__device__ __forceinline__ float silu_f(float x) { return x / (1.0f + __expf(-x)); }
__device__ __forceinline__ float wave_sum(float v) {
#pragma unroll
    for (int o = 1; o < 64; o <<= 1) v += __shfl_xor(v, o);
    return v;
}
__device__ __forceinline__ float wave_max(float v) {
#pragma unroll
    for (int o = 1; o < 64; o <<= 1) v = fmaxf(v, __shfl_xor(v, o));
    return v;
}

namespace pg8 {
#define PG8_LAS __attribute__((address_space(3)))
constexpr int BM = 256, BK = 64, HALF = 128, HTB = HALF * BK * 2  , STAGE_BYTES = 8 * HTB, NXCD = 8, WGM = 8;

__host__ __device__ __forceinline__ int lds_byte(int r, int c) { const int st = (r >> 4) * 2 + (c >> 5), rr = r & 15, cc = c & 31, ob = rr * 64 + cc * 2; return st * 1024 + (ob ^ (((ob >> 9) & 1) << 5)); }
__host__ __device__ __forceinline__ void stage_rc(int b, int& R, int& C) { const int st = b / 1024, sb = b % 1024, swz = sb ^ (((sb >> 9) & 1) << 5); R = (st >> 1) * 16 + swz / 64; C = (st & 1) * 32 + (swz % 64) / 2; }
__host__ __device__ __forceinline__ int perm32(int rho) { const int n = rho >> 4, i = rho & 15; return 8 * (i >> 2) + 4 * n + (i & 3); }

struct Unit { int pm, pn; };
struct Gemm { const bf16_t* A; const bf16_t* Bt; int M, N, K, lda, ldb; size_t a_pn_bytes; };

struct StaticOrder {
    int nM, nN, nwg, G, c;
    __host__ __device__ void init(int M_, int N_, int G_, int c_) { nM = M_ / BM; nN = N_ / BM; nwg = nM * nN; G = G_; c = c_; }
    __host__ __device__ bool next(int i, Unit& u) const {
        const long L = (long)i * G + c; if (L >= nwg) return false;
        int wgid = (int)L; { const int q = nwg / NXCD, r = nwg % NXCD, xcd = wgid % NXCD, off = wgid / NXCD; wgid = (xcd < r ? xcd * (q + 1) : r * (q + 1) + (xcd - r) * q) + off; }
        const int nig = WGM * nN, gid = wgid / nig, fm = gid * WGM, gsz = (nM - fm) < WGM ? (nM - fm) : WGM;
        u.pm = fm + ((wgid % nig) % gsz); u.pn = (wgid % nig) / gsz; return true;
    }
    __device__ __forceinline__ void a_ready(const Unit&) const {}
    __device__ __forceinline__ void done(const Unit&) const {}
};


struct EpiBf16Side {
    static constexpr bool PERM = true, AFTER_DRAIN = false;
    bf16_t* O; const float* bias; float* out; int mode, j;
    __device__ __forceinline__ void operator()(const f32x4 (&acc)[2][2][4][2], const Unit& u, int wr, int wc, int fr, int fq) const {
        const int ldc = mode == 0 ? QKV_N : SSM_INP;
        const int side_lo = mode == 0 ? KCOL : XBC_COL, side_hi = mode == 0 ? QKV_N : DT_COL, split = mode == 0 ? VCOL : (1 << 30), side_w = mode == 0 ? 256 : CONV_D;
        const int tailP = mode == 0 ? WIN : 3, rowsP = tailP, tailS = mode == 0 ? SL : 3, rowsS = mode == 0 ? WIN : 3;
        const int colt = u.pn * BM;
        const int c8 = colt + wc * 32 + 8 * fq;
        f32x4 bv[2][2];
#pragma unroll
        for (int bj = 0; bj < 2; ++bj)
#pragma unroll
            for (int n = 0; n < 2; ++n) bv[bj][n] = bias ? *(const f32x4*)(bias + c8 + bj * HALF + 4 * n) : (f32x4){0.f, 0.f, 0.f, 0.f};
        const bool has_side = (colt >= side_lo) && (colt < side_hi);
        const bool second = colt >= split;
        const int corg = second ? split : side_lo;
        float* sideP = out + (mode == 0 ? (second ? O_VP : O_KP) + (size_t)j * PB * WIN * 256 : O_CP);
        float* sideS = out + (mode == 0 ? (second ? O_VS : O_KS) + (size_t)j * SB * WIN * 256 : O_CS);
#pragma unroll
        for (int ai = 0; ai < 2; ++ai)
#pragma unroll
            for (int m = 0; m < 4; ++m) {
                const int row = u.pm * BM + ai * HALF + wr * 64 + m * 16 + fr;
                bf16_t* rowp = O + (size_t)row * ldc + c8;
                float* sp = nullptr;
                if (has_side) {
                    if (row < MP) { const int pos = row & (PL - 1), b = row >> 11; if (pos >= PL - tailP) sp = sideP + ((size_t)b * rowsP + (pos - (PL - tailP))) * side_w; }
                    else { const int rs = row - MP, b = rs >> 3, i = rs & 7; if (i >= SL - tailS) sp = sideS + ((size_t)b * rowsS + (rowsS - tailS) + (i - (SL - tailS))) * side_w; }
                }
#pragma unroll
                for (int bj = 0; bj < 2; ++bj) {
                    const f32x4 v0 = acc[ai][bj][m][0] + bv[bj][0], v1 = acc[ai][bj][m][1] + bv[bj][1];
                    u32x4 w; w.x = pk2(v0[0], v0[1]); w.y = pk2(v0[2], v0[3]); w.z = pk2(v1[0], v1[1]); w.w = pk2(v1[2], v1[3]);
                    *(u32x4*)(rowp + bj * HALF) = w;
                    if (sp) { float* q = sp + (c8 + bj * HALF - corg); *(f32x4*)q = v0; *(f32x4*)(q + 4) = v1; }
                }
                asm volatile("" ::: "memory");
            }
    }
};

struct EpiSwiGLU {
    static constexpr bool PERM = true, AFTER_DRAIN = false;
    bf16_t* O; int ldc;
    __device__ __forceinline__ void operator()(const f32x4 (&acc)[2][2][4][2], const Unit& u, int wr, int wc, int fr, int fq) const {
        const int c8 = u.pn * HALF + wc * 32 + 8 * fq;
#pragma unroll
        for (int ai = 0; ai < 2; ++ai)
#pragma unroll
            for (int m = 0; m < 4; ++m) {
                const int row = u.pm * BM + ai * HALF + wr * 64 + m * 16 + fr;
                const f32x4 g0 = acc[ai][0][m][0], g1 = acc[ai][0][m][1], u0 = acc[ai][1][m][0], u1 = acc[ai][1][m][1];
                u32x4 w;
                w.x = pk2(silu_f(g0[0]) * u0[0], silu_f(g0[1]) * u0[1]); w.y = pk2(silu_f(g0[2]) * u0[2], silu_f(g0[3]) * u0[3]);
                w.z = pk2(silu_f(g1[0]) * u1[0], silu_f(g1[1]) * u1[1]); w.w = pk2(silu_f(g1[2]) * u1[2], silu_f(g1[3]) * u1[3]);
                *(u32x4*)(O + (size_t)row * ldc + c8) = w;
                asm volatile("" ::: "memory");
            }
    }
};

struct EpiRes {
    static constexpr bool PERM = false, AFTER_DRAIN = false;
    float* Z; const float* baseP; const float* baseS; const float* bias; const float* scale;
    __device__ __forceinline__ void operator()(const f32x4 (&acc)[2][2][4][2], const Unit& u, int wr, int wc, int fr, int fq) const {
        const int col0 = u.pn * BM + wc * 32 + 4 * fq;
        f32x4 bv[2][2], sv[2][2];
#pragma unroll
        for (int bj = 0; bj < 2; ++bj)
#pragma unroll
            for (int n = 0; n < 2; ++n) {
                bv[bj][n] = bias ? *(const f32x4*)(bias + col0 + bj * HALF + n * 16) : (f32x4){0.f, 0.f, 0.f, 0.f};
                sv[bj][n] = scale ? *(const f32x4*)(scale + col0 + bj * HALF + n * 16) : (f32x4){1.f, 1.f, 1.f, 1.f};
            }
#pragma unroll
        for (int ai = 0; ai < 2; ++ai)
#pragma unroll
            for (int m = 0; m < 4; ++m) {
                const int row = u.pm * BM + ai * HALF + wr * 64 + m * 16 + fr;
                const float* bp = (row < MP ? baseP + (size_t)row * D : baseS + (size_t)(row - MP) * D) + col0;
                float* zp = Z + (size_t)row * D + col0;
#pragma unroll
                for (int bj = 0; bj < 2; ++bj)
#pragma unroll
                    for (int n = 0; n < 2; ++n) {
                        const f32x4 b = *(const f32x4*)(bp + bj * HALF + n * 16);
                        *(f32x4*)(zp + bj * HALF + n * 16) = b * ALPHA + (acc[ai][bj][m][n] + bv[bj][n]) * sv[bj][n];
                    }
                asm volatile("" ::: "memory");
            }
    }
};

template <class Epi, class Sched, bool ALIGN_EPI = false, bool SP2 = false>
__device__ __forceinline__ void gemm_phase(PG8_LAS unsigned char* lds, const Gemm g, const Sched& S, const Epi& E, const int tid) {
    const int wid = __builtin_amdgcn_readfirstlane(tid >> 6), lane = tid & 63, wr = wid >> 2, wc = wid & 3, fr = lane & 15, fq = lane >> 4;
    const int K = g.K, nt = K / BK, lda = g.lda, ldb = g.ldb;
    unsigned voffA[2], voffB[2];
#pragma unroll
    for (int i = 0; i < 2; ++i) { int R, C; stage_rc(tid * 16 + i * 8192, R, C); const int Rb = Epi::PERM ? ((R & ~31) + perm32(R & 31)) : R;
        voffA[i] = (unsigned)(R * lda + C) * 2u; voffB[i] = (unsigned)(Rb * ldb + C) * 2u; }
    const size_t kstep = (size_t)(BK * 2);
    const size_t hstepA = (size_t)HALF * lda * 2, hstepB = (size_t)HALF * ldb * 2;
    const size_t tstepA = 2 * hstepA, tstepB = 2 * hstepB;
    const size_t apn = g.a_pn_bytes;
    const unsigned ldsw = (unsigned)wid * 1024u;
    const int aoff = lds_byte(wr * 64 + fr, fq * 8), boff = lds_byte(wc * 32 + fr, fq * 8);
#define PG8_SA(b, h) (((b) * 2 + (h)) * HTB)
#define PG8_SB(b, h) ((4 + (b) * 2 + (h)) * HTB)
#define PG8_STAGE(bufoff, gbase, voff) do { _Pragma("unroll") for (int _i = 0; _i < 2; ++_i) \
        __builtin_amdgcn_global_load_lds((const unsigned*)((const char*)(gbase) + (voff)[_i]), (PG8_LAS unsigned*)(lds + (bufoff) + ldsw + _i * 8192), 16, 0, 0); } while (0)
#define PG8_LDA(dst, b, h) do { _Pragma("unroll") for (int m = 0; m < 4; ++m) _Pragma("unroll") for (int k = 0; k < 2; ++k) dst[m][k] = *(const PG8_LAS bf16x8*)(lds + PG8_SA(b, h) + aoff + m * 2048 + k * 1024); } while (0)
#define PG8_LDB(dst, b, h) do { _Pragma("unroll") for (int n = 0; n < 2; ++n) _Pragma("unroll") for (int k = 0; k < 2; ++k) dst[n][k] = *(const PG8_LAS bf16x8*)(lds + PG8_SB(b, h) + boff + n * 2048 + k * 1024); } while (0)
#define PG8_MMA(ai, bj, At, Bt) do { __builtin_amdgcn_s_setprio(1); _Pragma("unroll") for (int m = 0; m < 4; ++m) _Pragma("unroll") for (int n = 0; n < 2; ++n) _Pragma("unroll") for (int k = 0; k < 2; ++k) \
        acc[ai][bj][m][n] = __builtin_amdgcn_mfma_f32_16x16x32_bf16(Bt[n][k], At[m][k], acc[ai][bj][m][n], 0, 0, 0); __builtin_amdgcn_s_setprio(0); } while (0)
#define PG8_WAIT_V(n) asm volatile("s_waitcnt vmcnt(" #n ")" ::: "memory")
#define PG8_WAIT_L(n) asm volatile("s_waitcnt lgkmcnt(" #n ")" ::: "memory")
#define PG8_BAR __builtin_amdgcn_s_barrier()
#define PG8_SCHED __builtin_amdgcn_sched_barrier(0)
    Unit cur, nxt; int ui = 0;
    if (!S.next(0, cur)) return;
    f32x4 acc[2][2][4][2];
#pragma unroll
    for (int a = 0; a < 2; ++a)
#pragma unroll
        for (int b = 0; b < 2; ++b)
#pragma unroll
            for (int m = 0; m < 4; ++m)
#pragma unroll
                for (int n = 0; n < 2; ++n) acc[a][b][m][n] = (f32x4){0.f, 0.f, 0.f, 0.f};
    bf16x8 At[4][2], B0[2][2], B1[2][2];
    const char* cA = (const char*)g.A + (size_t)cur.pm * tstepA + (size_t)cur.pn * apn; const char* cB = (const char*)g.Bt + (size_t)cur.pn * tstepB;
    S.a_ready(cur);
    if constexpr (SP2) {
        PG8_STAGE(PG8_SB(0, 0), cB, voffB); PG8_STAGE(PG8_SB(0, 1), cB + hstepB, voffB); PG8_STAGE(PG8_SA(0, 0), cA, voffA); PG8_STAGE(PG8_SA(0, 1), cA + hstepA, voffA);
        if (wr == 1) PG8_BAR;
        PG8_WAIT_V(2); PG8_BAR;
        PG8_STAGE(PG8_SB(1, 0), cB + kstep, voffB); PG8_STAGE(PG8_SA(1, 0), cA + kstep, voffA); PG8_STAGE(PG8_SB(1, 1), cB + hstepB + kstep, voffB);
        PG8_WAIT_V(6); PG8_BAR;
    } else {
        PG8_STAGE(PG8_SB(0, 0), cB, voffB); PG8_STAGE(PG8_SA(0, 0), cA, voffA); PG8_STAGE(PG8_SB(0, 1), cB + hstepB, voffB); PG8_STAGE(PG8_SA(0, 1), cA + hstepA, voffA);
        if (wr == 1) PG8_BAR;
        PG8_WAIT_V(4); PG8_BAR;
        PG8_STAGE(PG8_SB(1, 0), cB + kstep, voffB); PG8_STAGE(PG8_SA(1, 0), cA + kstep, voffA); PG8_STAGE(PG8_SB(1, 1), cB + hstepB + kstep, voffB);
        PG8_WAIT_V(6); PG8_BAR;
    }
    for (;;) {
        const bool has_next = S.next(ui + 1, nxt);
        const char* nA = has_next ? (const char*)g.A + (size_t)nxt.pm * tstepA + (size_t)nxt.pn * apn : cA; const char* nB = has_next ? (const char*)g.Bt + (size_t)nxt.pn * tstepB : cB;
        for (int t = 0; t < nt; t += 2) {
            const bool last = (t == nt - 2);
            const char* a1 = cA + (size_t)(t + 1) * kstep;
            const char* a2 = last ? nA : cA + (size_t)(t + 2) * kstep; const char* b2 = last ? nB : cB + (size_t)(t + 2) * kstep;
            const char* a3 = a2 + kstep; const char* b3 = b2 + kstep;
            if (last && has_next) S.a_ready(nxt);
            if constexpr (SP2) {
            PG8_LDB(B0, 0, 0); PG8_LDB(B1, 0, 1); PG8_SCHED; PG8_LDA(At, 0, 0); PG8_STAGE(PG8_SA(1, 1), a1 + hstepA, voffA);
            PG8_WAIT_V(8); PG8_WAIT_L(0); PG8_BAR; PG8_MMA(0, 0, At, B0); PG8_MMA(0, 1, At, B1); PG8_BAR; PG8_SCHED;
            PG8_LDA(At, 0, 1); PG8_STAGE(PG8_SB(0, 0), b2, voffB); PG8_STAGE(PG8_SB(0, 1), b2 + hstepB, voffB); PG8_STAGE(PG8_SA(0, 0), a2, voffA);
            PG8_WAIT_V(8); PG8_WAIT_L(0); PG8_BAR; PG8_MMA(1, 0, At, B0); PG8_MMA(1, 1, At, B1); PG8_BAR; PG8_SCHED;
            PG8_LDB(B0, 1, 0); PG8_LDB(B1, 1, 1); PG8_SCHED; PG8_LDA(At, 1, 0); PG8_STAGE(PG8_SA(0, 1), a2 + hstepA, voffA);
            PG8_WAIT_V(8); PG8_WAIT_L(0); PG8_BAR; PG8_MMA(0, 0, At, B0); PG8_MMA(0, 1, At, B1); PG8_BAR; PG8_SCHED;
            PG8_LDA(At, 1, 1); PG8_STAGE(PG8_SB(1, 0), b3, voffB); PG8_STAGE(PG8_SB(1, 1), b3 + hstepB, voffB); PG8_STAGE(PG8_SA(1, 0), a3, voffA);
            PG8_WAIT_V(8); PG8_WAIT_L(0); PG8_BAR; PG8_MMA(1, 0, At, B0); PG8_MMA(1, 1, At, B1); PG8_BAR; PG8_SCHED;
            } else {
            PG8_LDB(B0, 0, 0); PG8_SCHED; PG8_LDA(At, 0, 0); PG8_STAGE(PG8_SA(1, 1), a1 + hstepA, voffA);
            PG8_WAIT_L(8); PG8_BAR; PG8_WAIT_L(0); PG8_MMA(0, 0, At, B0); PG8_BAR; PG8_SCHED;
            PG8_LDB(B1, 0, 1); PG8_STAGE(PG8_SB(0, 0), b2, voffB);
            PG8_BAR; PG8_WAIT_L(0); PG8_MMA(0, 1, At, B1); PG8_BAR;
            PG8_LDA(At, 0, 1); PG8_STAGE(PG8_SA(0, 0), a2, voffA);
            PG8_BAR; PG8_WAIT_L(0); PG8_MMA(1, 0, At, B0); PG8_BAR; PG8_SCHED;
            PG8_STAGE(PG8_SB(0, 1), b2 + hstepB, voffB);
            PG8_WAIT_V(6); PG8_BAR; PG8_MMA(1, 1, At, B1); PG8_BAR;
            PG8_LDB(B0, 1, 0); PG8_SCHED; PG8_LDA(At, 1, 0); PG8_STAGE(PG8_SA(0, 1), a2 + hstepA, voffA);
            PG8_WAIT_L(8); PG8_BAR; PG8_WAIT_L(0); PG8_MMA(0, 0, At, B0); PG8_BAR; PG8_SCHED;
            PG8_LDB(B1, 1, 1); PG8_STAGE(PG8_SB(1, 0), b3, voffB);
            PG8_BAR; PG8_WAIT_L(0); PG8_MMA(0, 1, At, B1); PG8_BAR;
            PG8_LDA(At, 1, 1); PG8_STAGE(PG8_SA(1, 0), a3, voffA);
            PG8_BAR; PG8_WAIT_L(0); PG8_MMA(1, 0, At, B0); PG8_BAR; PG8_SCHED;
            PG8_STAGE(PG8_SB(1, 1), b3 + hstepB, voffB);
            PG8_WAIT_V(6); PG8_BAR; PG8_MMA(1, 1, At, B1); PG8_BAR;
            }
        }
        if constexpr (ALIGN_EPI) { if (wr == 0) PG8_BAR; }
        if constexpr (!Epi::AFTER_DRAIN) { E(acc, cur, wr, wc, fr, fq); S.done(cur); }
        if (!has_next) break;
#pragma unroll
        for (int a = 0; a < 2; ++a)
#pragma unroll
            for (int b = 0; b < 2; ++b)
#pragma unroll
                for (int m = 0; m < 4; ++m)
#pragma unroll
                    for (int n = 0; n < 2; ++n) acc[a][b][m][n] = (f32x4){0.f, 0.f, 0.f, 0.f};
        cur = nxt; cA = nA; cB = nB; ++ui;
        if constexpr (ALIGN_EPI) { if (wr == 1) PG8_BAR; }
    }
    PG8_WAIT_V(0);
    if constexpr (!ALIGN_EPI) { if (wr == 0) PG8_BAR; }
    PG8_BAR;
    if constexpr (Epi::AFTER_DRAIN) { E.fused(acc, cur, wr, wc, fr, fq, lds, wid, lane); S.done(cur); }
#undef PG8_SA
#undef PG8_SB
#undef PG8_STAGE
#undef PG8_LDA
#undef PG8_LDB
#undef PG8_MMA
#undef PG8_WAIT_V
#undef PG8_WAIT_L
#undef PG8_BAR
#undef PG8_SCHED
}
}

constexpr int NWAVES = 8, NTHREADS = NWAVES * 64;
constexpr int RING_BYTES = 131072;
constexpr int MISC_OFF = RING_BYTES + 320;
constexpr int LDS_BYTES = 147456;

struct Ptrs {
    const float* in[28];
    float* out;
    unsigned char* ws;
    int ph_lo, ph_hi;
};
typedef const __attribute__((address_space(4))) Ptrs* KP;

__device__ __forceinline__ void p0_item(const float* W, int N, bf16_t* WT, int ldk, int k0, int n0, int dst_row0, LAS float* scr, int lane) {
#pragma unroll 8
    for (int i = 0; i < 32; ++i) { const int kk = 2 * i + (lane >> 5); scr[kk * 33 + (lane & 31)] = W[(size_t)(k0 + kk) * N + n0 + (lane & 31)]; }
    asm volatile("s_waitcnt lgkmcnt(0)" ::: "memory");
    const int c = lane & 7;
#pragma unroll
    for (int j = 0; j < 4; ++j) { const int n = (lane >> 3) + 8 * j; const LAS float* s = scr + (8 * c) * 33 + n;
        u32x4 o; o.x = pk2(s[0 * 33], s[1 * 33]); o.y = pk2(s[2 * 33], s[3 * 33]); o.z = pk2(s[4 * 33], s[5 * 33]); o.w = pk2(s[6 * 33], s[7 * 33]);
        *(u32x4*)(WT + (size_t)(dst_row0 + n) * ldk + k0 + 8 * c) = o; }
    asm volatile("s_waitcnt lgkmcnt(0)" ::: "memory");
}
__device__ __forceinline__ void p0_mat(const float* W, int K, int N, bf16_t* WT, int mode  , int r, LAS float* scr, int lane) {
    const int nblk = N / 32, kb = r / nblk, nb = r % nblk, k0 = 64 * kb, n0 = 32 * nb;
    int dr = n0;
    if (mode == 1) dr = 256 * (n0 >> 7) + (n0 & 127);
    if (mode == 2) dr = 256 * (n0 >> 7) + 128 + (n0 & 127);
    p0_item(W, N, WT, K, k0, n0, dr, scr, lane);
}
__device__ __forceinline__ void phase_prep(KP P, LAS unsigned char* lds, int gw, int NGW, int wave, int lane) {
    LAS float* scr = (LAS float*)(lds + wave * 16384);
    unsigned char* ws = P->ws;
    constexpr int I_QKV = 16 * 48, I_O = 16 * 32, I_IN = 16 * 161, I_OUT = 32 * 32, I_POOL = 4 * 8, I_G = 16 * 88, I_DN = 44 * 32;
    constexpr int N_ITEMS = 2 * I_QKV + 2 * I_O + I_IN + I_OUT + 4 * I_POOL + 4 * (2 * I_G + I_DN);
    for (int it = gw; it < N_ITEMS; it += NGW) {
        int r = it;
        if (r < 2 * I_QKV) { const int j = r / I_QKV; r -= j * I_QKV; p0_mat(P->in[8] + (size_t)j * D * QKV_N, D, QKV_N, (bf16_t*)(ws + WS_WQKV) + (size_t)j * QKV_N * D, 0, r, scr, lane); continue; } r -= 2 * I_QKV;
        if (r < 2 * I_O) { const int j = r / I_O; r -= j * I_O; p0_mat(P->in[10] + (size_t)j * D * D, D, D, (bf16_t*)(ws + WS_WO) + (size_t)j * D * D, 0, r, scr, lane); continue; } r -= 2 * I_O;
        if (r < I_IN) { p0_mat(P->in[13], D, SSM_IN, (bf16_t*)(ws + WS_WIN), 0, r, scr, lane); continue; } r -= I_IN;
        if (r < I_OUT) { p0_mat(P->in[20], DI, D, (bf16_t*)(ws + WS_WOUT), 0, r, scr, lane); continue; } r -= I_OUT;
        if (r < 4 * I_POOL) { const int g = r / I_POOL; r -= g * I_POOL; p0_mat(P->in[21] + (size_t)g * 256 * 256, 256, 256, (bf16_t*)(ws + WS_WPOOL) + (size_t)g * 256 * 256, 0, r, scr, lane); continue; } r -= 4 * I_POOL;
        { const int per = 2 * I_G + I_DN, i = r / per; r -= i * per;
          if (r < I_G) { p0_mat(P->in[23] + (size_t)i * D * FF, D, FF, (bf16_t*)(ws + WS_WGU) + (size_t)i * GU_N * D, 1, r, scr, lane); continue; } r -= I_G;
          if (r < I_G) { p0_mat(P->in[24] + (size_t)i * D * FF, D, FF, (bf16_t*)(ws + WS_WGU) + (size_t)i * GU_N * D, 2, r, scr, lane); continue; } r -= I_G;
          p0_mat(P->in[25] + (size_t)i * FF * D, FF, D, (bf16_t*)(ws + WS_WD) + (size_t)i * D * FF, 0, r, scr, lane); }
    }
    { const int gt = gw * 64 + lane, NT = NGW * 64; u32x4* z = (u32x4*)((bf16_t*)(ws + WS_WIN) + (size_t)SSM_IN * D);
      for (int i = gt; i < (SSM_INP - SSM_IN) * D / 8; i += NT) z[i] = (u32x4){0u, 0u, 0u, 0u}; }
    { const int gt = gw * 64 + lane, NT = NGW * 64; bf16_t* XB = (bf16_t*)(ws + WS_XB);
      for (int i = gt; i < M * D / 8; i += NT) { const int row = i >> 7, c = (i & 127) * 8;
          const float* src = (row < MP ? P->in[0] + (size_t)row * D : P->in[1] + (size_t)(row - MP) * D) + c;
          const f32x4 a = *(const f32x4*)src, b = *(const f32x4*)(src + 4);
          u32x4 w; w.x = pk2(a[0], a[1]); w.y = pk2(a[2], a[3]); w.z = pk2(b[0], b[1]); w.w = pk2(b[2], b[3]);
          *(u32x4*)(XB + (size_t)row * D + c) = w; } }
}

__device__ __forceinline__ void phase_ln(const float* Z, const float* g, const float* b, float* XF, bf16_t* XB, int gw, int NGW, int lane) {
    f32x4 gv[4], bv[4];
#pragma unroll
    for (int j = 0; j < 4; ++j) { gv[j] = *(const f32x4*)(g + 256 * j + 4 * lane); bv[j] = *(const f32x4*)(b + 256 * j + 4 * lane); }
    for (int row = gw; row < M; row += NGW) {
        const float* zr = Z + (size_t)row * D + 4 * lane;
        f32x4 v[4]; float s = 0.f;
#pragma unroll
        for (int j = 0; j < 4; ++j) { v[j] = *(const f32x4*)(zr + 256 * j); s += (v[j][0] + v[j][1]) + (v[j][2] + v[j][3]); }
        const float mean = wave_sum(s) * (1.f / D); float s2 = 0.f;
#pragma unroll
        for (int j = 0; j < 4; ++j) { v[j] = v[j] - mean; s2 += (v[j][0] * v[j][0] + v[j][1] * v[j][1]) + (v[j][2] * v[j][2] + v[j][3] * v[j][3]); }
        const float rstd = 1.0f / sqrtf(wave_sum(s2) * (1.f / D) + LN_EPS);
        float* xo = XF + (size_t)row * D + 4 * lane; bf16_t* bo = XB + (size_t)row * D + 4 * lane;
#pragma unroll
        for (int j = 0; j < 4; ++j) { const f32x4 o = v[j] * rstd * gv[j] + bv[j]; *(f32x4*)(xo + 256 * j) = o;
            u32x2 w; w.x = pk2(o[0], o[1]); w.y = pk2(o[2], o[3]); *(u32x2*)(bo + 256 * j) = w; }
    }
}

__device__ __forceinline__ int t5_bucket(int n) {
    if (n < 16) return n;
    const int l = 16 + (int)(__log2f((float)n * (1.0f / 16.0f)) * (16.0f / 3.0f));
    return l < 31 ? l : 31;
}
typedef float f32x16 __attribute__((ext_vector_type(16)));
constexpr int AT_KSTR = 72, AT_VSTR = 260;
constexpr int AT_TBL = 0, AT_K = 16 * 192 * 4, AT_V = AT_K + 256 * AT_KSTR * 2, AT_END = AT_V + 64 * AT_VSTR * 2;
static_assert(AT_END <= RING_BYTES, "attention LDS");

__device__ __forceinline__ void attn_sub(const LAS bf16_t* Ks, const LAS bf16_t* Vts, const LAS float* tblh, const bf16x8 (&qf)[4], int kb0, int dist0, int kmin, float sink,
                                         bf16_t* orow  , int lane) {
    const int l31 = lane & 31, h = lane >> 5;
    f32x16 s[5];
#pragma unroll
    for (int kt = 0; kt < 5; ++kt) {
        f32x16 acc = {0.f, 0.f, 0.f, 0.f, 0.f, 0.f, 0.f, 0.f, 0.f, 0.f, 0.f, 0.f, 0.f, 0.f, 0.f, 0.f};
        const LAS bf16_t* kp = Ks + (kb0 + kt * 32 + l31) * AT_KSTR + 8 * h;
#pragma unroll
        for (int ds = 0; ds < 4; ++ds) { const bf16x8 a = *(const LAS bf16x8*)(kp + 16 * ds); acc = __builtin_amdgcn_mfma_f32_32x32x16_bf16(a, qf[ds], acc, 0, 0, 0); }
        s[kt] = acc;
    }
    float mx = sink;
#pragma unroll
    for (int kt = 0; kt < 5; ++kt)
#pragma unroll
        for (int r = 0; r < 16; ++r) {
            const int kb = kb0 + kt * 32 + (r & 3) + 8 * (r >> 2) + 4 * h;
            float v = s[kt][r] * 0.125f + tblh[dist0 - kb + 31];
            if (kb < kmin) v = -INFINITY;
            s[kt][r] = v; mx = fmaxf(mx, v);
        }
    mx = fmaxf(mx, __shfl_xor(mx, 32));
    float sum = 0.f;
#pragma unroll
    for (int kt = 0; kt < 5; ++kt)
#pragma unroll
        for (int r = 0; r < 16; ++r) { const float p = __expf(s[kt][r] - mx); s[kt][r] = p; sum += p; }
    sum += __shfl_xor(sum, 32);
    sum += __expf(sink - mx);
    const float inv = 1.0f / sum;
    f32x16 o0 = {0.f, 0.f, 0.f, 0.f, 0.f, 0.f, 0.f, 0.f, 0.f, 0.f, 0.f, 0.f, 0.f, 0.f, 0.f, 0.f}, o1 = o0;
#pragma unroll
    for (int kt = 0; kt < 5; ++kt)
#pragma unroll
        for (int s2 = 0; s2 < 2; ++s2) {
            u32x4 pw; pw.x = pk2(s[kt][8 * s2 + 0], s[kt][8 * s2 + 1]); pw.y = pk2(s[kt][8 * s2 + 2], s[kt][8 * s2 + 3]); pw.z = pk2(s[kt][8 * s2 + 4], s[kt][8 * s2 + 5]); pw.w = pk2(s[kt][8 * s2 + 6], s[kt][8 * s2 + 7]);
            const bf16x8 pb = __builtin_bit_cast(bf16x8, pw);
            const LAS bf16_t* vp = Vts + l31 * AT_VSTR + kb0 + kt * 32 + 16 * s2 + 4 * h;
            { const u32x2 lo = *(const LAS u32x2*)vp, hi = *(const LAS u32x2*)(vp + 8); const u32x4 aw = {lo.x, lo.y, hi.x, hi.y};
              o0 = __builtin_amdgcn_mfma_f32_32x32x16_bf16(__builtin_bit_cast(bf16x8, aw), pb, o0, 0, 0, 0); }
            { const u32x2 lo = *(const LAS u32x2*)(vp + 32 * AT_VSTR), hi = *(const LAS u32x2*)(vp + 32 * AT_VSTR + 8); const u32x4 aw = {lo.x, lo.y, hi.x, hi.y};
              o1 = __builtin_amdgcn_mfma_f32_32x32x16_bf16(__builtin_bit_cast(bf16x8, aw), pb, o1, 0, 0, 0); }
        }
#pragma unroll
    for (int rg = 0; rg < 4; ++rg) {
        u32x2 w0, w1;
        w0.x = pk2(o0[4 * rg] * inv, o0[4 * rg + 1] * inv); w0.y = pk2(o0[4 * rg + 2] * inv, o0[4 * rg + 3] * inv);
        w1.x = pk2(o1[4 * rg] * inv, o1[4 * rg + 1] * inv); w1.y = pk2(o1[4 * rg + 2] * inv, o1[4 * rg + 3] * inv);
        *(u32x2*)(orow + 8 * rg + 4 * h) = w0; *(u32x2*)(orow + 32 + 8 * rg + 4 * h) = w1;
    }
}

__device__ __forceinline__ void phase_attn(const bf16_t* QKV, bf16_t* O, const float* ck, const float* cv, const float* rel_bias, const float* sinks,
                                           float* kS, float* vS, LAS unsigned char* lds, int tid, int wave, int lane) {
    LAS float* tbl = (LAS float*)(lds + AT_TBL);
    LAS bf16_t* Ks = (LAS bf16_t*)(lds + AT_K);
    LAS bf16_t* Vts = (LAS bf16_t*)(lds + AT_V);
    for (int i = tid; i < 16 * 192; i += NTHREADS) { const int hd = i / 192, dist = (i - hd * 192) - 31; tbl[i] = (dist >= 0 && dist < WIN) ? rel_bias[t5_bucket(dist) * NHQ + hd] : -INFINITY; }
    const int l31 = lane & 31, h = lane >> 5;
    for (int u = blockIdx.x; u < 1024; u += gridDim.x) {
        __syncthreads();
        if (u < 512) {
            const int kv = u & 3, qb = (u >> 2) & 15, b = u >> 6;
            const int prow0 = b * PL + qb * 128 - 128;
#pragma unroll
            for (int i = 0; i < 4; ++i) { const int pi = tid + NTHREADS * i, r = pi >> 3, c = pi & 7;
                u32x4 v = {0u, 0u, 0u, 0u};
                if (qb > 0 || r >= 128) v = *(const u32x4*)(QKV + (size_t)(prow0 + r) * QKV_N + KCOL + kv * HD + c * 8);
                *(LAS u32x4*)(Ks + r * AT_KSTR + c * 8) = v; }
#pragma unroll
            for (int i = 0; i < 2; ++i) { const int task = tid + NTHREADS * i, kp = task >> 3, dc = task & 7;
                u32x4 v0 = {0u, 0u, 0u, 0u}, v1 = v0;
                if (qb > 0 || kp >= 64) { const bf16_t* vp = QKV + (size_t)(prow0 + 2 * kp) * QKV_N + VCOL + kv * HD + dc * 8; v0 = *(const u32x4*)vp; v1 = *(const u32x4*)(vp + QKV_N); }
                LAS unsigned* d = (LAS unsigned*)(Vts + (dc * 8) * AT_VSTR + 2 * kp);
                d[0 * (AT_VSTR / 2)] = (v0.x & 0xffffu) | (v1.x << 16); d[1 * (AT_VSTR / 2)] = (v0.x >> 16) | (v1.x & 0xffff0000u);
                d[2 * (AT_VSTR / 2)] = (v0.y & 0xffffu) | (v1.y << 16); d[3 * (AT_VSTR / 2)] = (v0.y >> 16) | (v1.y & 0xffff0000u);
                d[4 * (AT_VSTR / 2)] = (v0.z & 0xffffu) | (v1.z << 16); d[5 * (AT_VSTR / 2)] = (v0.z >> 16) | (v1.z & 0xffff0000u);
                d[6 * (AT_VSTR / 2)] = (v0.w & 0xffffu) | (v1.w << 16); d[7 * (AT_VSTR / 2)] = (v0.w >> 16) | (v1.w & 0xffff0000u); }
            __syncthreads();
            const int g = wave >> 1, qh = wave & 1, head = kv * 4 + g;
            const float sink = sinks[head];
#pragma unroll 1
            for (int sbk = 0; sbk < 2; ++sbk) {
                const int q0 = qh * 64 + sbk * 32;
                const size_t row = (size_t)b * PL + qb * 128 + q0 + l31;
                bf16x8 qf[4];
#pragma unroll
                for (int ds = 0; ds < 4; ++ds) qf[ds] = *(const bf16x8*)(QKV + row * QKV_N + head * HD + 16 * ds + 8 * h);
                attn_sub(Ks, Vts, tbl + head * 192, qf, q0, q0 + l31 + 128, qb == 0 ? 128 : 0, sink, O + row * D + head * HD, lane);
            }
        } else {
            const int us = u - 512, kv = us & 3, b = us >> 2;
            for (int pi = tid; pi < 160 * 8; pi += NTHREADS) { const int r = pi >> 3, c = pi & 7;
                u32x4 kw = {0u, 0u, 0u, 0u}, v0 = kw;
                if (r < WIN) { const size_t src = ((size_t)(b * WIN + r) * NKV + kv) * HD + c * 8;
                    const f32x4 a = *(const f32x4*)(ck + src), a2 = *(const f32x4*)(ck + src + 4), e = *(const f32x4*)(cv + src), e2 = *(const f32x4*)(cv + src + 4);
                    kw.x = pk2(a[0], a[1]); kw.y = pk2(a[2], a[3]); kw.z = pk2(a2[0], a2[1]); kw.w = pk2(a2[2], a2[3]);
                    v0.x = pk2(e[0], e[1]); v0.y = pk2(e[2], e[3]); v0.z = pk2(e2[0], e2[1]); v0.w = pk2(e2[2], e2[3]);
                    if (r >= SL) { const size_t dst = ((size_t)(b * WIN + r - SL) * NKV + kv) * HD + c * 8;
                        *(f32x4*)(kS + dst) = a; *(f32x4*)(kS + dst + 4) = a2; *(f32x4*)(vS + dst) = e; *(f32x4*)(vS + dst + 4) = e2; }
                } else if (r < WIN + SL) { const bf16_t* p = QKV + (size_t)(MP + b * SL + (r - WIN)) * QKV_N + kv * HD + c * 8; kw = *(const u32x4*)(p + KCOL); v0 = *(const u32x4*)(p + VCOL); }
                *(LAS u32x4*)(Ks + r * AT_KSTR + c * 8) = kw;
                LAS bf16_t* d = Vts + (c * 8) * AT_VSTR + r;
                d[0 * AT_VSTR] = (bf16_t)(v0.x & 0xffffu); d[1 * AT_VSTR] = (bf16_t)(v0.x >> 16); d[2 * AT_VSTR] = (bf16_t)(v0.y & 0xffffu); d[3 * AT_VSTR] = (bf16_t)(v0.y >> 16);
                d[4 * AT_VSTR] = (bf16_t)(v0.z & 0xffffu); d[5 * AT_VSTR] = (bf16_t)(v0.z >> 16); d[6 * AT_VSTR] = (bf16_t)(v0.w & 0xffffu); d[7 * AT_VSTR] = (bf16_t)(v0.w >> 16); }
            __syncthreads();
            if (wave == 0) {
                const int g = l31 >> 3, si = l31 & 7, head = kv * 4 + g;
                const size_t row = (size_t)MP + b * SL + si;
                bf16x8 qf[4];
#pragma unroll
                for (int ds = 0; ds < 4; ++ds) qf[ds] = *(const bf16x8*)(QKV + row * QKV_N + head * HD + 16 * ds + 8 * h);
                attn_sub(Ks, Vts, tbl + head * 192, qf, 0, 128 + si, 0, sinks[head], O + row * D + head * HD, lane);
            }
        }
    }
}

constexpr int SSD_CH = 64;
__device__ __forceinline__ void phase_ssd(KP P, LAS unsigned char* lds, int tid) {
    const bf16_t* ZX = (const bf16_t*)(P->ws + WS_ZX); bf16_t* Y = (bf16_t*)(P->ws + WS_Y);
    const float* conv_w = P->in[14]; const float* conv_b = P->in[15]; const float* dt_bias = P->in[16]; const float* a_log = P->in[17]; const float* dsk = P->in[18];
    const float* st_conv = P->in[4]; const float* st_ssm = P->in[5];
    LAS float* xs = (LAS float*)lds;
    LAS float* Bs = xs + SSD_CH * 64;
    LAS float* Cs = Bs + SSD_CH * 128;
    LAS float* ys = Cs + SSD_CH * 128;
    LAS float* dts = ys + SSD_CH * 64;
    LAS float* dAs = dts + SSD_CH;
    const int p = tid >> 3, nb = tid & 7;
    for (int u = blockIdx.x; u < PB * SH + SB * SH; u += gridDim.x) {
        const bool smp = u >= PB * SH;
        const int uu = smp ? u - PB * SH : u;
        const int b = uu >> 5, h = uu & 31, g = h >> 3;
        const int row0 = smp ? MP + b * SL : b * PL, T = smp ? SL : PL;
        const float a = -__expf(a_log[h]), dtb = dt_bias[h], Dh = dsk[h];
        float hr[16];
        const size_t hoff = (((size_t)b * SH + h) * SP + p) * SN + nb * 16;
        if (smp) {
#pragma unroll
            for (int i = 0; i < 4; ++i) { const f32x4 v = *(const f32x4*)(st_ssm + hoff + 4 * i); hr[4 * i] = v[0]; hr[4 * i + 1] = v[1]; hr[4 * i + 2] = v[2]; hr[4 * i + 3] = v[3]; }
        } else {
#pragma unroll
            for (int i = 0; i < 16; ++i) hr[i] = 0.f;
        }
        for (int t0 = 0; t0 < T; t0 += SSD_CH) {
            const int Tc = (T - t0) < SSD_CH ? (T - t0) : SSD_CH;
            for (int idx = tid; idx < Tc * 320; idx += NTHREADS) {
                const int t = idx / 320, ch = idx - t * 320;
                const int cc = ch < 64 ? h * 64 + ch : (ch < 192 ? DI + g * 128 + (ch - 64) : DI + 512 + g * 128 + (ch - 192));
                float v = conv_b[cc];
#pragma unroll
                for (int j = 0; j < 4; ++j) {
                    const int tt = t0 + t - 3 + j;
                    float r;
                    if (tt >= 0) r = bf1(ZX[(size_t)(row0 + tt) * SSM_INP + XBC_COL + cc]);
                    else r = smp ? st_conv[((size_t)b * 3 + (3 + tt)) * CONV_D + cc] : 0.f;
                    v += conv_w[j * CONV_D + cc] * r;
                }
                v = silu_f(v);
                if (ch < 64) xs[t * 64 + ch] = v; else if (ch < 192) Bs[t * 128 + (ch - 64)] = v; else Cs[t * 128 + (ch - 192)] = v;
            }
            if (tid < Tc) {
                const float raw = bf1(ZX[(size_t)(row0 + t0 + tid) * SSM_INP + DT_COL + h]) + dtb;
                const float dtv = raw > 20.f ? raw : log1pf(__expf(raw));
                dts[tid] = dtv; dAs[tid] = __expf(dtv * a);
            }
            __syncthreads();
            for (int t = 0; t < Tc; ++t) {
                const float dA = dAs[t], xv = xs[t * 64 + p], xdt = xv * dts[t];
                float acc = 0.f;
#pragma unroll
                for (int i = 0; i < 4; ++i) {
                    const f32x4 Bv = *(const LAS f32x4*)(Bs + t * 128 + nb * 16 + 4 * i), Cv = *(const LAS f32x4*)(Cs + t * 128 + nb * 16 + 4 * i);
#pragma unroll
                    for (int e = 0; e < 4; ++e) { hr[4 * i + e] = hr[4 * i + e] * dA + xdt * Bv[e]; acc += Cv[e] * hr[4 * i + e]; }
                }
                acc += __shfl_xor(acc, 1); acc += __shfl_xor(acc, 2); acc += __shfl_xor(acc, 4);
                if (nb == 0) ys[t * 64 + p] = acc + Dh * xv;
            }
            __syncthreads();
            for (int idx = tid; idx < Tc * 32; idx += NTHREADS) { const int t = idx >> 5, c2 = (idx & 31) * 2;
                *(unsigned*)(Y + (size_t)(row0 + t0 + t) * DI + h * 64 + c2) = pk2(ys[t * 64 + c2], ys[t * 64 + c2 + 1]); }
            __syncthreads();
        }
        float* ho = P->out + (smp ? O_SS : O_SP) + hoff;
#pragma unroll
        for (int i = 0; i < 4; ++i) *(f32x4*)(ho + 4 * i) = (f32x4){hr[4 * i], hr[4 * i + 1], hr[4 * i + 2], hr[4 * i + 3]};
    }
}

__device__ __forceinline__ void phase_gnorm(KP P, int gw, int NGW, int lane) {
    const bf16_t* ZX = (const bf16_t*)(P->ws + WS_ZX); bf16_t* Y = (bf16_t*)(P->ws + WS_Y); const float* nw = P->in[19];
    for (int u = gw; u < M * 4; u += NGW) {
        const int row = u >> 2, c = (u & 3) * 512 + lane * 8;
        const u32x4 yw = *(const u32x4*)(Y + (size_t)row * DI + c), zw = *(const u32x4*)(ZX + (size_t)row * SSM_INP + c);
        float v[8];
        v[0] = bflo(yw.x) * silu_f(bflo(zw.x)); v[1] = bfhi(yw.x) * silu_f(bfhi(zw.x)); v[2] = bflo(yw.y) * silu_f(bflo(zw.y)); v[3] = bfhi(yw.y) * silu_f(bfhi(zw.y));
        v[4] = bflo(yw.z) * silu_f(bflo(zw.z)); v[5] = bfhi(yw.z) * silu_f(bfhi(zw.z)); v[6] = bflo(yw.w) * silu_f(bflo(zw.w)); v[7] = bfhi(yw.w) * silu_f(bfhi(zw.w));
        float ss = 0.f;
#pragma unroll
        for (int e = 0; e < 8; ++e) ss += v[e] * v[e];
        const float r = 1.0f / sqrtf(wave_sum(ss) * (1.0f / 512.0f) + RMS_EPS);
        const f32x4 w0 = *(const f32x4*)(nw + c), w1 = *(const f32x4*)(nw + c + 4);
        u32x4 o; o.x = pk2(v[0] * r * w0[0], v[1] * r * w0[1]); o.y = pk2(v[2] * r * w0[2], v[3] * r * w0[3]); o.z = pk2(v[4] * r * w1[0], v[5] * r * w1[1]); o.w = pk2(v[6] * r * w1[2], v[7] * r * w1[3]);
        *(u32x4*)(Y + (size_t)row * DI + c) = o;
    }
}

__device__ __forceinline__ void phase_pooldiff(KP P, int gw, int NGW, int lane) {
    const float* XF = P->out; const float* spool = P->in[6]; bf16_t* DF = (bf16_t*)(P->ws + WS_DIFF);
    const int gt = gw * 64 + lane, NT = NGW * 64;
    for (int i = gt; i < M * 256; i += NT) {
        const int row = i >> 8, c4 = (i & 255) * 4, w = 2 << (c4 >> 8);
        f32x4 s = (f32x4){0.f, 0.f, 0.f, 0.f}; float cnt;
        const f32x4 x = *(const f32x4*)(XF + (size_t)row * D + c4);
        if (row < MP) { const int pos = row & (PL - 1); const int n = (pos + 1) < w ? (pos + 1) : w; cnt = (float)n;
            for (int j = 0; j < n; ++j) s += *(const f32x4*)(XF + (size_t)(row - j) * D + c4); }
        else { const int rs = row - MP, b = rs >> 3, si = rs & 7; cnt = (float)w;
            for (int j = 0; j < w; ++j) { const int r = 15 + si - j;
                s += (r >= 15) ? *(const f32x4*)(XF + (size_t)(MP + b * SL + r - 15) * D + c4) : *(const f32x4*)(spool + ((size_t)b * 15 + r) * D + c4); } }
        const f32x4 d = s / cnt - x;
        u32x2 o; o.x = pk2(d[0], d[1]); o.y = pk2(d[2], d[3]);
        *(u32x2*)(DF + (size_t)row * D + c4) = o;
    }
    for (int i = gt; i < PB * 15 * 256; i += NT) { const int c4 = (i & 255) * 4, r = (i >> 8) % 15, b = (i >> 8) / 15;
        *(f32x4*)(P->out + O_PP + ((size_t)b * 15 + r) * D + c4) = *(const f32x4*)(XF + (size_t)(b * PL + PL - 15 + r) * D + c4); }
    for (int i = gt; i < SB * 15 * 256; i += NT) { const int c4 = (i & 255) * 4, r = (i >> 8) % 15, b = (i >> 8) / 15;
        *(f32x4*)(P->out + O_PS + ((size_t)b * 15 + r) * D + c4) = (r < 7) ? *(const f32x4*)(spool + ((size_t)b * 15 + 8 + r) * D + c4) : *(const f32x4*)(XF + (size_t)(MP + b * SL + r - 7) * D + c4); }
}

typedef GAS unsigned gu32;
#define XB_TMO      128
#define XB_XCNT(j)  (256  + 64 * (j))
#define XB_XSUB(j)  (1280 + 64 * (j))
#define XB_XGEN(j)  (2304 + 64 * (j))
#define XB_TOP      3328
#define XB_TOPGEN   3392
#define XCD_BAR_WORDS 3456
#define XB_SPIN_CAP (1u << 18)
__device__ __forceinline__ unsigned xb_ld(unsigned* p)              { return __hip_atomic_load(p, __ATOMIC_RELAXED, __HIP_MEMORY_SCOPE_AGENT); }
__device__ __forceinline__ unsigned xb_add(unsigned* p, unsigned v) { return __hip_atomic_fetch_add(p, v, __ATOMIC_RELAXED, __HIP_MEMORY_SCOPE_AGENT); }
__device__ __forceinline__ unsigned xb_xcc_id() { return (unsigned)__builtin_amdgcn_s_getreg((3 << 11) | 20) & 0xFu; }
#define XB_SPIN(cond, bar) do { unsigned _sp = 0; while (cond) { __builtin_amdgcn_s_sleep(1); \
    if ((++_sp & 255u) == 0u) { if (xb_ld(&(bar)[XB_TMO])) break; if (_sp > XB_SPIN_CAP) { atomicAdd(&(bar)[XB_TMO], 1u); break; } } } } while (0)
struct XcdBarrier { unsigned* bar; unsigned x; volatile LAS unsigned* st; };
__device__ __forceinline__ XcdBarrier xcd_barrier_post(unsigned* bar, volatile LAS unsigned* st) {
    XcdBarrier b; b.bar = bar; b.x = xb_xcc_id(); b.st = st;
    if (threadIdx.x == 0) (void)xb_add(&bar[XB_XCNT(b.x)], 1u);
    return b;
}
__device__ __forceinline__ void xcd_barrier_complete(unsigned* bar, unsigned x, unsigned& nloc, unsigned& nx) {
    const unsigned G = gridDim.x * gridDim.y * gridDim.z;
    unsigned sum, cnt, mine, sp = 0u;
    for (;;) {
        sum = 0u; cnt = 0u; mine = 0u;
#pragma unroll
        for (unsigned j = 0; j < 16; ++j) { const unsigned c = xb_ld(&bar[XB_XCNT(j)]); sum += c; cnt += (c > 0u) ? 1u : 0u; mine = (j == x) ? c : mine; }
        if (sum == G) break;
        __builtin_amdgcn_s_sleep(1);
        if ((++sp & 255u) == 0u) { if (xb_ld(&bar[XB_TMO])) break; if (sp > XB_SPIN_CAP) { atomicAdd(&bar[XB_TMO], 1u); break; } }
    }
    nloc = mine > 0u ? mine : 1u; nx = cnt > 0u ? cnt : 1u;
}
__device__ __forceinline__ void xcd_barrier(const XcdBarrier& b) {
    asm volatile("s_waitcnt vmcnt(0)" ::: "memory");
    __syncthreads();
    if (threadIdx.x == 0) {
        unsigned* bar = b.bar;
        __builtin_amdgcn_s_waitcnt(0);
        unsigned nloc = b.st[0], nx = b.st[1];
        if (nloc == 0u) { xcd_barrier_complete(bar, b.x, nloc, nx); b.st[0] = nloc; b.st[1] = nx; }
        const unsigned old = xb_add(&bar[XB_XSUB(b.x)], 1u);
        const unsigned gen = old / nloc;
        if (old + 1u == (gen + 1u) * nloc) {
            __builtin_amdgcn_fence(__ATOMIC_RELEASE, "agent");
            asm volatile("s_waitcnt vmcnt(0)" ::: "memory");
            const unsigned og = xb_add(&bar[XB_TOP], 1u);
            const unsigned tg = og / nx;
            if (og + 1u == (tg + 1u) * nx) xb_add(&bar[XB_TOPGEN], 1u);
            else XB_SPIN(xb_ld(&bar[XB_TOPGEN]) == tg, bar);
            __builtin_amdgcn_fence(__ATOMIC_ACQUIRE, "agent");
            xb_add(&bar[XB_XGEN(b.x)], 1u);
            asm volatile("s_waitcnt vmcnt(0)" ::: "memory");
        } else {
            XB_SPIN(xb_ld(&bar[XB_XGEN(b.x)]) == gen, bar);
            __builtin_amdgcn_fence(__ATOMIC_ACQUIRE, "agent");
            asm volatile("s_waitcnt vmcnt(0)" ::: "memory");
        }
    }
    __syncthreads();
}

#ifndef MK_PER_PHASE
#define MK_PER_PHASE 0
#endif
constexpr int N_PHASES = 29;
enum { OP_PREP = 0, OP_GEMM_SIDE, OP_ATTN, OP_GEMM_RES, OP_LN, OP_GEMM_UP, OP_SSD, OP_GNORM, OP_DIFF };

__global__ void __launch_bounds__(NTHREADS, 2) fwd_kernel(Ptrs Parg) {
    extern __shared__ __attribute__((aligned(16))) unsigned char lds_raw[];
    LAS unsigned char* lds = (LAS unsigned char*)lds_raw;
    const int ph_lo = Parg.ph_lo, ph_hi = Parg.ph_hi;
    {
        const int tid0 = threadIdx.x;
        for (int u = tid0; u < (LDS_BYTES - RING_BYTES) / 4; u += NTHREADS) ((LAS unsigned*)(lds + RING_BYTES))[u] = 0u;
        __syncthreads();
        if (ph_hi - ph_lo > 1) { if (tid0 == 0) (void)xb_add(&((unsigned*)(Parg.ws + WS_CTL) + 4096)[XB_XCNT(xb_xcc_id())], 1u); }
    }
    for (int ph = ph_lo; ph < ph_hi; ++ph) {
        int tid = threadIdx.x; asm volatile("" : "+v"(tid));
        KP P = (KP)__builtin_amdgcn_kernarg_segment_ptr(); asm volatile("" : "+s"(P));
        int bx = blockIdx.x; asm volatile("" : "+s"(bx));
        const int lane = tid & 63, wave = __builtin_amdgcn_readfirstlane(tid >> 6);
        const int G = gridDim.x;
        const int vcu = (G % 8 == 0) ? (bx % 8) * (G / 8) + bx / 8 : bx;
        const int gw = vcu * NWAVES + wave, NGW = G * NWAVES;
        unsigned char* ws = P->ws;
        bf16_t* XB = (bf16_t*)(ws + WS_XB);
        float* Z = (float*)(ws + WS_Z);
        float* XF = P->out;
        int op = OP_PREP, L = 0, t = 0;
        if (ph > 0) {
            const int q = ph - 1; int sub;
            if (q < 7) { L = 0; sub = q; } else if (q < 15) { L = 1; sub = q - 7; } else if (q < 21) { L = 2; sub = q - 15; } else { L = 3; sub = q - 21; }
            const int kind = L == 1 ? 1 : (L == 2 ? 2 : 0);
            const int npre = kind == 0 ? 2 : (kind == 1 ? 3 : 1);
            if (sub < npre) { op = kind == 0 ? (sub == 0 ? OP_GEMM_SIDE : OP_ATTN) : (kind == 1 ? (sub == 0 ? OP_GEMM_SIDE : (sub == 1 ? OP_SSD : OP_GNORM)) : OP_DIFF); }
            else { t = sub - npre; op = (t == 0 || t == 3) ? OP_GEMM_RES : ((t == 1 || t == 4) ? OP_LN : OP_GEMM_UP); }
        }
        const int kind = L == 1 ? 1 : (L == 2 ? 2 : 0);
        const int j = L / 3;
#ifndef ONLY_OP
#define ONLY_OP -1
#endif
#define EN(o) (ONLY_OP < 0 || ONLY_OP == (o))
        if (EN(OP_PREP) && op == OP_PREP) {
            phase_prep(P, lds, gw, NGW, wave, lane);
        } else if (EN(OP_GEMM_SIDE) && op == OP_GEMM_SIDE) {
            pg8::Gemm g; pg8::EpiBf16Side E;
            g.A = XB; g.M = M; g.K = D; g.lda = D; g.ldb = D; g.a_pn_bytes = 0;
            E.out = P->out; E.j = j;
            if (kind == 0) { g.Bt = (const bf16_t*)(ws + WS_WQKV) + (size_t)j * QKV_N * D; g.N = QKV_N; E.O = (bf16_t*)(ws + WS_QKV); E.bias = P->in[9] + j * QKV_N; E.mode = 0; }
            else { g.Bt = (const bf16_t*)(ws + WS_WIN); g.N = SSM_INP; E.O = (bf16_t*)(ws + WS_ZX); E.bias = nullptr; E.mode = 1; }
            pg8::StaticOrder S; S.init(M, g.N, G, bx);
            pg8::gemm_phase<pg8::EpiBf16Side, pg8::StaticOrder, true, true>(lds, g, S, E, tid);
        } else if (EN(OP_ATTN) && op == OP_ATTN) {
            phase_attn((const bf16_t*)(ws + WS_QKV), (bf16_t*)(ws + WS_O), P->in[2] + (size_t)j * SB * WIN * 256, P->in[3] + (size_t)j * SB * WIN * 256, P->in[7], P->in[12] + j * NHQ,
                       P->out + O_KS + (size_t)j * SB * WIN * 256, P->out + O_VS + (size_t)j * SB * WIN * 256, lds, tid, wave, lane);
        } else if (EN(OP_GEMM_RES) && op == OP_GEMM_RES) {
            pg8::Gemm g; pg8::EpiRes E;
            g.M = M; g.N = D; g.a_pn_bytes = 0;
            E.Z = Z; E.bias = nullptr; E.scale = nullptr;
            if (L == 0 && t == 0) { E.baseP = P->in[0]; E.baseS = P->in[1]; } else { E.baseP = XF; E.baseS = XF + (size_t)MP * D; }
            if (t == 3) { g.A = (const bf16_t*)(ws + WS_H); g.lda = FF; g.Bt = (const bf16_t*)(ws + WS_WD) + (size_t)L * D * FF; g.ldb = FF; g.K = FF; }
            else if (kind == 0) { g.A = (const bf16_t*)(ws + WS_O); g.lda = D; g.Bt = (const bf16_t*)(ws + WS_WO) + (size_t)j * D * D; g.ldb = D; g.K = D; E.bias = P->in[11] + j * D; }
            else if (kind == 1) { g.A = (const bf16_t*)(ws + WS_Y); g.lda = DI; g.Bt = (const bf16_t*)(ws + WS_WOUT); g.ldb = DI; g.K = DI; }
            else { g.A = (const bf16_t*)(ws + WS_DIFF); g.lda = D; g.Bt = (const bf16_t*)(ws + WS_WPOOL); g.ldb = 256; g.K = 256; g.a_pn_bytes = 512; E.scale = P->in[22]; }
            pg8::StaticOrder S; S.init(M, D, G, bx);
            pg8::gemm_phase<pg8::EpiRes, pg8::StaticOrder, true, true>(lds, g, S, E, tid);
        } else if (EN(OP_LN) && op == OP_LN) {
            const int which = (t == 1) ? 0 : 1;
            phase_ln(Z, P->in[26] + (size_t)(L * 2 + which) * D, P->in[27] + (size_t)(L * 2 + which) * D, XF, XB, gw, NGW, lane);
        } else if (EN(OP_GEMM_UP) && op == OP_GEMM_UP) {
            pg8::Gemm g; g.A = XB; g.Bt = (const bf16_t*)(ws + WS_WGU) + (size_t)L * GU_N * D; g.M = M; g.N = GU_N; g.K = D; g.lda = D; g.ldb = D; g.a_pn_bytes = 0;
            pg8::EpiSwiGLU E; E.O = (bf16_t*)(ws + WS_H); E.ldc = FF;
            pg8::StaticOrder S; S.init(M, GU_N, G, bx);
            pg8::gemm_phase<pg8::EpiSwiGLU, pg8::StaticOrder, true, true>(lds, g, S, E, tid);
        } else if (EN(OP_SSD) && op == OP_SSD) {
            phase_ssd(P, lds, tid);
        } else if (EN(OP_GNORM) && op == OP_GNORM) {
            phase_gnorm(P, gw, NGW, lane);
        } else if (EN(OP_DIFF) && op == OP_DIFF) {
            phase_pooldiff(P, gw, NGW, lane);
        }
        if (ph + 1 < ph_hi) { XcdBarrier bar; bar.bar = (unsigned*)(P->ws + WS_CTL) + 4096; bar.x = xb_xcc_id(); bar.st = (volatile LAS unsigned*)(lds + MISC_OFF) + 8; xcd_barrier(bar); }
    }
}

extern "C" void kernel_launch(void* const* d_in, const int* in_sizes, int n_in, void* d_out, int out_size, void* d_ws, size_t ws_size, hipStream_t stream) {
    static int grid = 0;
    if (grid == 0) {
        if (n_in != 28 || out_size != (int)O_END || ws_size < WS_END) { fprintf(stderr, "kernel_launch: unexpected shapes (n_in %d, out %d, ws %zu)\n", n_in, out_size, ws_size); grid = -1; return; }
        int dev = 0, cus = 0;
        if (hipGetDevice(&dev) != hipSuccess || hipDeviceGetAttribute(&cus, hipDeviceAttributeMultiprocessorCount, dev) != hipSuccess) { grid = -1; return; }
        if (hipFuncSetAttribute((const void*)fwd_kernel, hipFuncAttributeMaxDynamicSharedMemorySize, LDS_BYTES) != hipSuccess) { fprintf(stderr, "kernel_launch: hipFuncSetAttribute failed\n"); grid = -1; return; }
        (void)hipGetLastError();
        grid = cus;
    }
    if (grid < 0) return;
    (void)hipMemsetAsync((char*)d_ws + WS_CTL, 0, CTL_ZERO_BYTES, stream);
    Ptrs a{};
    for (int i = 0; i < 28; ++i) a.in[i] = (const float*)d_in[i];
    a.out = (float*)d_out; a.ws = (unsigned char*)d_ws;
#if MK_PER_PHASE
    for (int ph = 0; ph < N_PHASES; ++ph) { a.ph_lo = ph; a.ph_hi = ph + 1; hipLaunchKernelGGL(fwd_kernel, dim3(grid), dim3(NTHREADS), LDS_BYTES, stream, a); }
#else
    a.ph_lo = 0; a.ph_hi = N_PHASES;
    hipLaunchKernelGGL(fwd_kernel, dim3(grid), dim3(NTHREADS), LDS_BYTES, stream, a);
#endif
}
```

```cpp
#include <hip/hip_runtime.h>
#include <cstdio>
#include <cstdint>

#define LAS __attribute__((address_space(3)))
#define GAS __attribute__((address_space(1)))
typedef unsigned short bf16_t;
typedef short bf16x8 __attribute__((ext_vector_type(8)));
typedef float f32x4 __attribute__((ext_vector_type(4)));
typedef float f32x2 __attribute__((ext_vector_type(2)));
typedef unsigned u32x4 __attribute__((ext_vector_type(4)));
typedef unsigned u32x2 __attribute__((ext_vector_type(2)));

constexpr int D = 1024;
constexpr int PB = 8, PL = 2048, MP = PB * PL;
constexpr int SB = 128, SL = 8, MS = SB * SL;
constexpr int M = MP + MS;
constexpr int NKV = 4, HD = 64, NHQ = 16, WIN = 128;
constexpr int QKV_N = 1536, KCOL = 1024, VCOL = 1280;
constexpr int FF = 2816, GU_N = 2 * FF;
constexpr int DI = 2048, CONV_D = 3072, SSM_IN = 5152, SSM_INP = 5376, SH = 32, SP = 64, SN = 128;
constexpr int XBC_COL = 2048, DT_COL = 5120;
constexpr int DEPTH = 4;
constexpr float LN_EPS = 1e-5f, RMS_EPS = 1e-5f;
constexpr float ALPHA = 1.6817928305074290f;

constexpr size_t O_Y = 0;
constexpr size_t O_KP = (size_t)M * D;
constexpr size_t O_VP = O_KP + (size_t)2 * PB * WIN * 256;
constexpr size_t O_CP = O_VP + (size_t)2 * PB * WIN * 256;
constexpr size_t O_SP = O_CP + (size_t)PB * 3 * CONV_D;
constexpr size_t O_PP = O_SP + (size_t)PB * SH * SP * SN;
constexpr size_t O_KS = O_PP + (size_t)PB * 15 * D;
constexpr size_t O_VS = O_KS + (size_t)2 * SB * WIN * 256;
constexpr size_t O_CS = O_VS + (size_t)2 * SB * WIN * 256;
constexpr size_t O_SS = O_CS + (size_t)SB * 3 * CONV_D;
constexpr size_t O_PS = O_SS + (size_t)SB * SH * SP * SN;
constexpr size_t O_END = O_PS + (size_t)SB * 15 * D;
static_assert(O_END == 74645504, "output size");

constexpr size_t MiB = 1u << 20;
constexpr size_t WS_CTL = 0, CTL_ZERO_BYTES = 1 * MiB;
constexpr size_t WS_WQKV = 1 * MiB;
constexpr size_t WS_WO = WS_WQKV + 6 * MiB;
constexpr size_t WS_WIN = WS_WO + 4 * MiB;
constexpr size_t WS_WOUT = WS_WIN + 11 * MiB;
constexpr size_t WS_WPOOL = WS_WOUT + 4 * MiB;
constexpr size_t WS_WGU = WS_WPOOL + 1 * MiB;
constexpr size_t WS_WD = WS_WGU + 44 * MiB;
constexpr size_t WS_XB = WS_WD + 22 * MiB;
constexpr size_t WS_Z = WS_XB + 34 * MiB;
constexpr size_t WS_BIG = WS_Z + 68 * MiB;
constexpr size_t WS_QKV = WS_BIG;
constexpr size_t WS_O = WS_BIG + 52 * MiB;
constexpr size_t WS_H = WS_BIG;
constexpr size_t WS_ZX = WS_BIG;
constexpr size_t WS_Y = WS_BIG + 180 * MiB;
constexpr size_t WS_DIFF = WS_BIG;
constexpr size_t WS_END = WS_BIG + 250 * MiB;
static_assert(WS_END <= 512 * MiB, "d_ws map");

__device__ __forceinline__ unsigned f2bf(float f) { unsigned u = __builtin_bit_cast(unsigned, f); return (u + 0x7fffu + ((u >> 16) & 1u)) >> 16; }
__device__ __forceinline__ unsigned pk2(float lo, float hi) { return f2bf(lo) | (f2bf(hi) << 16); }
__device__ __forceinline__ float bflo(unsigned w) { return __builtin_bit_cast(float, w << 16); }
__device__ __forceinline__ float bfhi(unsigned w) { return __builtin_bit_cast(float, w & 0xffff0000u); }
__device__ __forceinline__ float bf1(bf16_t h) { return __builtin_bit_cast(float, (unsigned)h << 16); }
__device__ __forceinline__ float silu_f(float x) { return x / (1.0f + __expf(-x)); }
__device__ __forceinline__ float wave_sum(float v) {
#pragma unroll
    for (int o = 1; o < 64; o <<= 1) v += __shfl_xor(v, o);
    return v;
}
__device__ __forceinline__ float wave_max(float v) {
#pragma unroll
    for (int o = 1; o < 64; o <<= 1) v = fmaxf(v, __shfl_xor(v, o));
    return v;
}

namespace pg8 {
#define PG8_LAS __attribute__((address_space(3)))
constexpr int BM = 256, BK = 64, HALF = 128, HTB = HALF * BK * 2  , STAGE_BYTES = 8 * HTB, NXCD = 8, WGM = 8;

__host__ __device__ __forceinline__ int lds_byte(int r, int c) { const int st = (r >> 4) * 2 + (c >> 5), rr = r & 15, cc = c & 31, ob = rr * 64 + cc * 2; return st * 1024 + (ob ^ (((ob >> 9) & 1) << 5)); }
__host__ __device__ __forceinline__ void stage_rc(int b, int& R, int& C) { const int st = b / 1024, sb = b % 1024, swz = sb ^ (((sb >> 9) & 1) << 5); R = (st >> 1) * 16 + swz / 64; C = (st & 1) * 32 + (swz % 64) / 2; }
__host__ __device__ __forceinline__ int perm32(int rho) { const int n = rho >> 4, i = rho & 15; return 8 * (i >> 2) + 4 * n + (i & 3); }

struct Unit { int pm, pn; };
struct Gemm { const bf16_t* A; const bf16_t* Bt; int M, N, K, lda, ldb; size_t a_pn_bytes; };

struct StaticOrder {
    int nM, nN, nwg, G, c;
    __host__ __device__ void init(int M_, int N_, int G_, int c_) { nM = M_ / BM; nN = N_ / BM; nwg = nM * nN; G = G_; c = c_; }
    __host__ __device__ bool next(int i, Unit& u) const {
        const long L = (long)i * G + c; if (L >= nwg) return false;
        int wgid = (int)L; { const int q = nwg / NXCD, r = nwg % NXCD, xcd = wgid % NXCD, off = wgid / NXCD; wgid = (xcd < r ? xcd * (q + 1) : r * (q + 1) + (xcd - r) * q) + off; }
        const int nig = WGM * nN, gid = wgid / nig, fm = gid * WGM, gsz = (nM - fm) < WGM ? (nM - fm) : WGM;
        u.pm = fm + ((wgid % nig) % gsz); u.pn = (wgid % nig) / gsz; return true;
    }
    __device__ __forceinline__ void a_ready(const Unit&) const {}
    __device__ __forceinline__ void done(const Unit&) const {}
};


struct EpiBf16Side {
    static constexpr bool PERM = true, AFTER_DRAIN = false;
    bf16_t* O; const float* bias; float* out; int mode, j;
    __device__ __forceinline__ void operator()(const f32x4 (&acc)[2][2][4][2], const Unit& u, int wr, int wc, int fr, int fq) const {
        const int ldc = mode == 0 ? QKV_N : SSM_INP;
        const int side_lo = mode == 0 ? KCOL : XBC_COL, side_hi = mode == 0 ? QKV_N : DT_COL, split = mode == 0 ? VCOL : (1 << 30), side_w = mode == 0 ? 256 : CONV_D;
        const int tailP = mode == 0 ? WIN : 3, rowsP = tailP, tailS = mode == 0 ? SL : 3, rowsS = mode == 0 ? WIN : 3;
        const int colt = u.pn * BM;
        const int c8 = colt + wc * 32 + 8 * fq;
        f32x4 bv[2][2];
#pragma unroll
        for (int bj = 0; bj < 2; ++bj)
#pragma unroll
            for (int n = 0; n < 2; ++n) bv[bj][n] = bias ? *(const f32x4*)(bias + c8 + bj * HALF + 4 * n) : (f32x4){0.f, 0.f, 0.f, 0.f};
        const bool has_side = (colt >= side_lo) && (colt < side_hi);
        const bool second = colt >= split;
        const int corg = second ? split : side_lo;
        float* sideP = out + (mode == 0 ? (second ? O_VP : O_KP) + (size_t)j * PB * WIN * 256 : O_CP);
        float* sideS = out + (mode == 0 ? (second ? O_VS : O_KS) + (size_t)j * SB * WIN * 256 : O_CS);
#pragma unroll
        for (int ai = 0; ai < 2; ++ai)
#pragma unroll
            for (int m = 0; m < 4; ++m) {
                const int row = u.pm * BM + ai * HALF + wr * 64 + m * 16 + fr;
                bf16_t* rowp = O + (size_t)row * ldc + c8;
                float* sp = nullptr;
                if (has_side) {
                    if (row < MP) { const int pos = row & (PL - 1), b = row >> 11; if (pos >= PL - tailP) sp = sideP + ((size_t)b * rowsP + (pos - (PL - tailP))) * side_w; }
                    else { const int rs = row - MP, b = rs >> 3, i = rs & 7; if (i >= SL - tailS) sp = sideS + ((size_t)b * rowsS + (rowsS - tailS) + (i - (SL - tailS))) * side_w; }
                }
#pragma unroll
                for (int bj = 0; bj < 2; ++bj) {
                    const f32x4 v0 = acc[ai][bj][m][0] + bv[bj][0], v1 = acc[ai][bj][m][1] + bv[bj][1];
                    u32x4 w; w.x = pk2(v0[0], v0[1]); w.y = pk2(v0[2], v0[3]); w.z = pk2(v1[0], v1[1]); w.w = pk2(v1[2], v1[3]);
                    *(u32x4*)(rowp + bj * HALF) = w;
                    if (sp) { float* q = sp + (c8 + bj * HALF - corg); *(f32x4*)q = v0; *(f32x4*)(q + 4) = v1; }
                }
                asm volatile("" ::: "memory");
            }
    }
};

struct EpiSwiGLU {
    static constexpr bool PERM = true, AFTER_DRAIN = false;
    bf16_t* O; int ldc;
    __device__ __forceinline__ void operator()(const f32x4 (&acc)[2][2][4][2], const Unit& u, int wr, int wc, int fr, int fq) const {
        const int c8 = u.pn * HALF + wc * 32 + 8 * fq;
#pragma unroll
        for (int ai = 0; ai < 2; ++ai)
#pragma unroll
            for (int m = 0; m < 4; ++m) {
                const int row = u.pm * BM + ai * HALF + wr * 64 + m * 16 + fr;
                const f32x4 g0 = acc[ai][0][m][0], g1 = acc[ai][0][m][1], u0 = acc[ai][1][m][0], u1 = acc[ai][1][m][1];
                u32x4 w;
                w.x = pk2(silu_f(g0[0]) * u0[0], silu_f(g0[1]) * u0[1]); w.y = pk2(silu_f(g0[2]) * u0[2], silu_f(g0[3]) * u0[3]);
                w.z = pk2(silu_f(g1[0]) * u1[0], silu_f(g1[1]) * u1[1]); w.w = pk2(silu_f(g1[2]) * u1[2], silu_f(g1[3]) * u1[3]);
                *(u32x4*)(O + (size_t)row * ldc + c8) = w;
                asm volatile("" ::: "memory");
            }
    }
};

struct EpiRes {
    static constexpr bool PERM = false, AFTER_DRAIN = false;
    float* Z; const float* baseP; const float* baseS; const float* bias; const float* scale;
    __device__ __forceinline__ void operator()(const f32x4 (&acc)[2][2][4][2], const Unit& u, int wr, int wc, int fr, int fq) const {
        const int col0 = u.pn * BM + wc * 32 + 4 * fq;
        f32x4 bv[2][2], sv[2][2];
#pragma unroll
        for (int bj = 0; bj < 2; ++bj)
#pragma unroll
            for (int n = 0; n < 2; ++n) {
                bv[bj][n] = bias ? *(const f32x4*)(bias + col0 + bj * HALF + n * 16) : (f32x4){0.f, 0.f, 0.f, 0.f};
                sv[bj][n] = scale ? *(const f32x4*)(scale + col0 + bj * HALF + n * 16) : (f32x4){1.f, 1.f, 1.f, 1.f};
            }
#pragma unroll
        for (int ai = 0; ai < 2; ++ai)
#pragma unroll
            for (int m = 0; m < 4; ++m) {
                const int row = u.pm * BM + ai * HALF + wr * 64 + m * 16 + fr;
                const float* bp = (row < MP ? baseP + (size_t)row * D : baseS + (size_t)(row - MP) * D) + col0;
                float* zp = Z + (size_t)row * D + col0;
#pragma unroll
                for (int bj = 0; bj < 2; ++bj)
#pragma unroll
                    for (int n = 0; n < 2; ++n) {
                        const f32x4 b = *(const f32x4*)(bp + bj * HALF + n * 16);
                        *(f32x4*)(zp + bj * HALF + n * 16) = b * ALPHA + (acc[ai][bj][m][n] + bv[bj][n]) * sv[bj][n];
                    }
                asm volatile("" ::: "memory");
            }
    }
};

template <class Epi, class Sched, bool ALIGN_EPI = false, bool SP2 = false>
__device__ __forceinline__ void gemm_phase(PG8_LAS unsigned char* lds, const Gemm g, const Sched& S, const Epi& E, const int tid) {
    const int wid = __builtin_amdgcn_readfirstlane(tid >> 6), lane = tid & 63, wr = wid >> 2, wc = wid & 3, fr = lane & 15, fq = lane >> 4;
    const int K = g.K, nt = K / BK, lda = g.lda, ldb = g.ldb;
    unsigned voffA[2], voffB[2];
#pragma unroll
    for (int i = 0; i < 2; ++i) { int R, C; stage_rc(tid * 16 + i * 8192, R, C); const int Rb = Epi::PERM ? ((R & ~31) + perm32(R & 31)) : R;
        voffA[i] = (unsigned)(R * lda + C) * 2u; voffB[i] = (unsigned)(Rb * ldb + C) * 2u; }
    const size_t kstep = (size_t)(BK * 2);
    const size_t hstepA = (size_t)HALF * lda * 2, hstepB = (size_t)HALF * ldb * 2;
    const size_t tstepA = 2 * hstepA, tstepB = 2 * hstepB;
    const size_t apn = g.a_pn_bytes;
    const unsigned ldsw = (unsigned)wid * 1024u;
    const int aoff = lds_byte(wr * 64 + fr, fq * 8), boff = lds_byte(wc * 32 + fr, fq * 8);
#define PG8_SA(b, h) (((b) * 2 + (h)) * HTB)
#define PG8_SB(b, h) ((4 + (b) * 2 + (h)) * HTB)
#define PG8_STAGE(bufoff, gbase, voff) do { _Pragma("unroll") for (int _i = 0; _i < 2; ++_i) \
        __builtin_amdgcn_global_load_lds((const unsigned*)((const char*)(gbase) + (voff)[_i]), (PG8_LAS unsigned*)(lds + (bufoff) + ldsw + _i * 8192), 16, 0, 0); } while (0)
#define PG8_LDA(dst, b, h) do { _Pragma("unroll") for (int m = 0; m < 4; ++m) _Pragma("unroll") for (int k = 0; k < 2; ++k) dst[m][k] = *(const PG8_LAS bf16x8*)(lds + PG8_SA(b, h) + aoff + m * 2048 + k * 1024); } while (0)
#define PG8_LDB(dst, b, h) do { _Pragma("unroll") for (int n = 0; n < 2; ++n) _Pragma("unroll") for (int k = 0; k < 2; ++k) dst[n][k] = *(const PG8_LAS bf16x8*)(lds + PG8_SB(b, h) + boff + n * 2048 + k * 1024); } while (0)
#define PG8_MMA(ai, bj, At, Bt) do { __builtin_amdgcn_s_setprio(1); _Pragma("unroll") for (int m = 0; m < 4; ++m) _Pragma("unroll") for (int n = 0; n < 2; ++n) _Pragma("unroll") for (int k = 0; k < 2; ++k) \
        acc[ai][bj][m][n] = __builtin_amdgcn_mfma_f32_16x16x32_bf16(Bt[n][k], At[m][k], acc[ai][bj][m][n], 0, 0, 0); __builtin_amdgcn_s_setprio(0); } while (0)
#define PG8_WAIT_V(n) asm volatile("s_waitcnt vmcnt(" #n ")" ::: "memory")
#define PG8_WAIT_L(n) asm volatile("s_waitcnt lgkmcnt(" #n ")" ::: "memory")
#define PG8_BAR __builtin_amdgcn_s_barrier()
#define PG8_SCHED __builtin_amdgcn_sched_barrier(0)
    Unit cur, nxt; int ui = 0;
    if (!S.next(0, cur)) return;
    f32x4 acc[2][2][4][2];
#pragma unroll
    for (int a = 0; a < 2; ++a)
#pragma unroll
        for (int b = 0; b < 2; ++b)
#pragma unroll
            for (int m = 0; m < 4; ++m)
#pragma unroll
                for (int n = 0; n < 2; ++n) acc[a][b][m][n] = (f32x4){0.f, 0.f, 0.f, 0.f};
    bf16x8 At[4][2], B0[2][2], B1[2][2];
    const char* cA = (const char*)g.A + (size_t)cur.pm * tstepA + (size_t)cur.pn * apn; const char* cB = (const char*)g.Bt + (size_t)cur.pn * tstepB;
    S.a_ready(cur);
    if constexpr (SP2) {
        PG8_STAGE(PG8_SB(0, 0), cB, voffB); PG8_STAGE(PG8_SB(0, 1), cB + hstepB, voffB); PG8_STAGE(PG8_SA(0, 0), cA, voffA); PG8_STAGE(PG8_SA(0, 1), cA + hstepA, voffA);
        if (wr == 1) PG8_BAR;
        PG8_WAIT_V(2); PG8_BAR;
        PG8_STAGE(PG8_SB(1, 0), cB + kstep, voffB); PG8_STAGE(PG8_SA(1, 0), cA + kstep, voffA); PG8_STAGE(PG8_SB(1, 1), cB + hstepB + kstep, voffB);
        PG8_WAIT_V(6); PG8_BAR;
    } else {
        PG8_STAGE(PG8_SB(0, 0), cB, voffB); PG8_STAGE(PG8_SA(0, 0), cA, voffA); PG8_STAGE(PG8_SB(0, 1), cB + hstepB, voffB); PG8_STAGE(PG8_SA(0, 1), cA + hstepA, voffA);
        if (wr == 1) PG8_BAR;
        PG8_WAIT_V(4); PG8_BAR;
        PG8_STAGE(PG8_SB(1, 0), cB + kstep, voffB); PG8_STAGE(PG8_SA(1, 0), cA + kstep, voffA); PG8_STAGE(PG8_SB(1, 1), cB + hstepB + kstep, voffB);
        PG8_WAIT_V(6); PG8_BAR;
    }
    for (;;) {
        const bool has_next = S.next(ui + 1, nxt);
        const char* nA = has_next ? (const char*)g.A + (size_t)nxt.pm * tstepA + (size_t)nxt.pn * apn : cA; const char* nB = has_next ? (const char*)g.Bt + (size_t)nxt.pn * tstepB : cB;
        for (int t = 0; t < nt; t += 2) {
            const bool last = (t == nt - 2);
            const char* a1 = cA + (size_t)(t + 1) * kstep;
            const char* a2 = last ? nA : cA + (size_t)(t + 2) * kstep; const char* b2 = last ? nB : cB + (size_t)(t + 2) * kstep;
            const char* a3 = a2 + kstep; const char* b3 = b2 + kstep;
            if (last && has_next) S.a_ready(nxt);
            if constexpr (SP2) {
            PG8_LDB(B0, 0, 0); PG8_LDB(B1, 0, 1); PG8_SCHED; PG8_LDA(At, 0, 0); PG8_STAGE(PG8_SA(1, 1), a1 + hstepA, voffA);
            PG8_WAIT_V(8); PG8_WAIT_L(0); PG8_BAR; PG8_MMA(0, 0, At, B0); PG8_MMA(0, 1, At, B1); PG8_BAR; PG8_SCHED;
            PG8_LDA(At, 0, 1); PG8_STAGE(PG8_SB(0, 0), b2, voffB); PG8_STAGE(PG8_SB(0, 1), b2 + hstepB, voffB); PG8_STAGE(PG8_SA(0, 0), a2, voffA);
            PG8_WAIT_V(8); PG8_WAIT_L(0); PG8_BAR; PG8_MMA(1, 0, At, B0); PG8_MMA(1, 1, At, B1); PG8_BAR; PG8_SCHED;
            PG8_LDB(B0, 1, 0); PG8_LDB(B1, 1, 1); PG8_SCHED; PG8_LDA(At, 1, 0); PG8_STAGE(PG8_SA(0, 1), a2 + hstepA, voffA);
            PG8_WAIT_V(8); PG8_WAIT_L(0); PG8_BAR; PG8_MMA(0, 0, At, B0); PG8_MMA(0, 1, At, B1); PG8_BAR; PG8_SCHED;
            PG8_LDA(At, 1, 1); PG8_STAGE(PG8_SB(1, 0), b3, voffB); PG8_STAGE(PG8_SB(1, 1), b3 + hstepB, voffB); PG8_STAGE(PG8_SA(1, 0), a3, voffA);
            PG8_WAIT_V(8); PG8_WAIT_L(0); PG8_BAR; PG8_MMA(1, 0, At, B0); PG8_MMA(1, 1, At, B1); PG8_BAR; PG8_SCHED;
            } else {
            PG8_LDB(B0, 0, 0); PG8_SCHED; PG8_LDA(At, 0, 0); PG8_STAGE(PG8_SA(1, 1), a1 + hstepA, voffA);
            PG8_WAIT_L(8); PG8_BAR; PG8_WAIT_L(0); PG8_MMA(0, 0, At, B0); PG8_BAR; PG8_SCHED;
            PG8_LDB(B1, 0, 1); PG8_STAGE(PG8_SB(0, 0), b2, voffB);
            PG8_BAR; PG8_WAIT_L(0); PG8_MMA(0, 1, At, B1); PG8_BAR;
            PG8_LDA(At, 0, 1); PG8_STAGE(PG8_SA(0, 0), a2, voffA);
            PG8_BAR; PG8_WAIT_L(0); PG8_MMA(1, 0, At, B0); PG8_BAR; PG8_SCHED;
            PG8_STAGE(PG8_SB(0, 1), b2 + hstepB, voffB);
            PG8_WAIT_V(6); PG8_BAR; PG8_MMA(1, 1, At, B1); PG8_BAR;
            PG8_LDB(B0, 1, 0); PG8_SCHED; PG8_LDA(At, 1, 0); PG8_STAGE(PG8_SA(0, 1), a2 + hstepA, voffA);
            PG8_WAIT_L(8); PG8_BAR; PG8_WAIT_L(0); PG8_MMA(0, 0, At, B0); PG8_BAR; PG8_SCHED;
            PG8_LDB(B1, 1, 1); PG8_STAGE(PG8_SB(1, 0), b3, voffB);
            PG8_BAR; PG8_WAIT_L(0); PG8_MMA(0, 1, At, B1); PG8_BAR;
            PG8_LDA(At, 1, 1); PG8_STAGE(PG8_SA(1, 0), a3, voffA);
            PG8_BAR; PG8_WAIT_L(0); PG8_MMA(1, 0, At, B0); PG8_BAR; PG8_SCHED;
            PG8_STAGE(PG8_SB(1, 1), b3 + hstepB, voffB);
            PG8_WAIT_V(6); PG8_BAR; PG8_MMA(1, 1, At, B1); PG8_BAR;
            }
        }
        if constexpr (ALIGN_EPI) { if (wr == 0) PG8_BAR; }
        if constexpr (!Epi::AFTER_DRAIN) { E(acc, cur, wr, wc, fr, fq); S.done(cur); }
        if (!has_next) break;
#pragma unroll
        for (int a = 0; a < 2; ++a)
#pragma unroll
            for (int b = 0; b < 2; ++b)
#pragma unroll
                for (int m = 0; m < 4; ++m)
#pragma unroll
                    for (int n = 0; n < 2; ++n) acc[a][b][m][n] = (f32x4){0.f, 0.f, 0.f, 0.f};
        cur = nxt; cA = nA; cB = nB; ++ui;
        if constexpr (ALIGN_EPI) { if (wr == 1) PG8_BAR; }
    }
    PG8_WAIT_V(0);
    if constexpr (!ALIGN_EPI) { if (wr == 0) PG8_BAR; }
    PG8_BAR;
    if constexpr (Epi::AFTER_DRAIN) { E.fused(acc, cur, wr, wc, fr, fq, lds, wid, lane); S.done(cur); }
#undef PG8_SA
#undef PG8_SB
#undef PG8_STAGE
#undef PG8_LDA
#undef PG8_LDB
#undef PG8_MMA
#undef PG8_WAIT_V
#undef PG8_WAIT_L
#undef PG8_BAR
#undef PG8_SCHED
}
}

constexpr int NWAVES = 8, NTHREADS = NWAVES * 64;
constexpr int RING_BYTES = 147456;
constexpr int MISC_OFF = RING_BYTES + 320;
constexpr int LDS_BYTES = 155648;

struct Ptrs {
    const float* in[28];
    float* out;
    unsigned char* ws;
    int ph_lo, ph_hi;
};
typedef const __attribute__((address_space(4))) Ptrs* KP;

__device__ __forceinline__ void p0_item(const float* W, int N, bf16_t* WT, int ldk, int k0, int n0, int dst_row0, LAS float* scr, int lane) {
#pragma unroll 8
    for (int i = 0; i < 32; ++i) { const int kk = 2 * i + (lane >> 5); scr[kk * 33 + (lane & 31)] = W[(size_t)(k0 + kk) * N + n0 + (lane & 31)]; }
    asm volatile("s_waitcnt lgkmcnt(0)" ::: "memory");
    const int c = lane & 7;
#pragma unroll
    for (int j = 0; j < 4; ++j) { const int n = (lane >> 3) + 8 * j; const LAS float* s = scr + (8 * c) * 33 + n;
        u32x4 o; o.x = pk2(s[0 * 33], s[1 * 33]); o.y = pk2(s[2 * 33], s[3 * 33]); o.z = pk2(s[4 * 33], s[5 * 33]); o.w = pk2(s[6 * 33], s[7 * 33]);
        *(u32x4*)(WT + (size_t)(dst_row0 + n) * ldk + k0 + 8 * c) = o; }
    asm volatile("s_waitcnt lgkmcnt(0)" ::: "memory");
}
__device__ __forceinline__ void p0_mat(const float* W, int K, int N, bf16_t* WT, int mode  , int r, LAS float* scr, int lane) {
    const int nblk = N / 32, kb = r / nblk, nb = r % nblk, k0 = 64 * kb, n0 = 32 * nb;
    int dr = n0;
    if (mode == 1) dr = 256 * (n0 >> 7) + (n0 & 127);
    if (mode == 2) dr = 256 * (n0 >> 7) + 128 + (n0 & 127);
    p0_item(W, N, WT, K, k0, n0, dr, scr, lane);
}
__device__ __forceinline__ void phase_prep(KP P, LAS unsigned char* lds, int gw, int NGW, int wave, int lane) {
    LAS float* scr = (LAS float*)(lds + wave * 16384);
    unsigned char* ws = P->ws;
    constexpr int I_QKV = 16 * 48, I_O = 16 * 32, I_IN = 16 * 161, I_OUT = 32 * 32, I_POOL = 4 * 8, I_G = 16 * 88, I_DN = 44 * 32;
    constexpr int N_ITEMS = 2 * I_QKV + 2 * I_O + I_IN + I_OUT + 4 * I_POOL + 4 * (2 * I_G + I_DN);
    for (int it = gw; it < N_ITEMS; it += NGW) {
        int r = it;
        if (r < 2 * I_QKV) { const int j = r / I_QKV; r -= j * I_QKV; p0_mat(P->in[8] + (size_t)j * D * QKV_N, D, QKV_N, (bf16_t*)(ws + WS_WQKV) + (size_t)j * QKV_N * D, 0, r, scr, lane); continue; } r -= 2 * I_QKV;
        if (r < 2 * I_O) { const int j = r / I_O; r -= j * I_O; p0_mat(P->in[10] + (size_t)j * D * D, D, D, (bf16_t*)(ws + WS_WO) + (size_t)j * D * D, 0, r, scr, lane); continue; } r -= 2 * I_O;
        if (r < I_IN) { p0_mat(P->in[13], D, SSM_IN, (bf16_t*)(ws + WS_WIN), 0, r, scr, lane); continue; } r -= I_IN;
        if (r < I_OUT) { p0_mat(P->in[20], DI, D, (bf16_t*)(ws + WS_WOUT), 0, r, scr, lane); continue; } r -= I_OUT;
        if (r < 4 * I_POOL) { const int g = r / I_POOL; r -= g * I_POOL; p0_mat(P->in[21] + (size_t)g * 256 * 256, 256, 256, (bf16_t*)(ws + WS_WPOOL) + (size_t)g * 256 * 256, 0, r, scr, lane); continue; } r -= 4 * I_POOL;
        { const int per = 2 * I_G + I_DN, i = r / per; r -= i * per;
          if (r < I_G) { p0_mat(P->in[23] + (size_t)i * D * FF, D, FF, (bf16_t*)(ws + WS_WGU) + (size_t)i * GU_N * D, 1, r, scr, lane); continue; } r -= I_G;
          if (r < I_G) { p0_mat(P->in[24] + (size_t)i * D * FF, D, FF, (bf16_t*)(ws + WS_WGU) + (size_t)i * GU_N * D, 2, r, scr, lane); continue; } r -= I_G;
          p0_mat(P->in[25] + (size_t)i * FF * D, FF, D, (bf16_t*)(ws + WS_WD) + (size_t)i * D * FF, 0, r, scr, lane); }
    }
    { const int gt = gw * 64 + lane, NT = NGW * 64; u32x4* z = (u32x4*)((bf16_t*)(ws + WS_WIN) + (size_t)SSM_IN * D);
      for (int i = gt; i < (SSM_INP - SSM_IN) * D / 8; i += NT) z[i] = (u32x4){0u, 0u, 0u, 0u}; }
    { const int gt = gw * 64 + lane, NT = NGW * 64; bf16_t* XB = (bf16_t*)(ws + WS_XB);
      for (int i = gt; i < M * D / 8; i += NT) { const int row = i >> 7, c = (i & 127) * 8;
          const float* src = (row < MP ? P->in[0] + (size_t)row * D : P->in[1] + (size_t)(row - MP) * D) + c;
          const f32x4 a = *(const f32x4*)src, b = *(const f32x4*)(src + 4);
          u32x4 w; w.x = pk2(a[0], a[1]); w.y = pk2(a[2], a[3]); w.z = pk2(b[0], b[1]); w.w = pk2(b[2], b[3]);
          *(u32x4*)(XB + (size_t)row * D + c) = w; } }
}

__device__ __forceinline__ void phase_ln(const float* Z, const float* g, const float* b, float* XF, bf16_t* XB, int gw, int NGW, int lane) {
    f32x4 gv[4], bv[4];
#pragma unroll
    for (int j = 0; j < 4; ++j) { gv[j] = *(const f32x4*)(g + 256 * j + 4 * lane); bv[j] = *(const f32x4*)(b + 256 * j + 4 * lane); }
    for (int row = gw; row < M; row += NGW) {
        const float* zr = Z + (size_t)row * D + 4 * lane;
        f32x4 v[4]; float s = 0.f;
#pragma unroll
        for (int j = 0; j < 4; ++j) { v[j] = *(const f32x4*)(zr + 256 * j); s += (v[j][0] + v[j][1]) + (v[j][2] + v[j][3]); }
        const float mean = wave_sum(s) * (1.f / D); float s2 = 0.f;
#pragma unroll
        for (int j = 0; j < 4; ++j) { v[j] = v[j] - mean; s2 += (v[j][0] * v[j][0] + v[j][1] * v[j][1]) + (v[j][2] * v[j][2] + v[j][3] * v[j][3]); }
        const float rstd = 1.0f / sqrtf(wave_sum(s2) * (1.f / D) + LN_EPS);
        float* xo = XF + (size_t)row * D + 4 * lane; bf16_t* bo = XB + (size_t)row * D + 4 * lane;
#pragma unroll
        for (int j = 0; j < 4; ++j) { const f32x4 o = v[j] * rstd * gv[j] + bv[j]; *(f32x4*)(xo + 256 * j) = o;
            u32x2 w; w.x = pk2(o[0], o[1]); w.y = pk2(o[2], o[3]); *(u32x2*)(bo + 256 * j) = w; }
    }
}

__device__ __forceinline__ int t5_bucket(int n) {
    if (n < 16) return n;
    const int l = 16 + (int)(__log2f((float)n * (1.0f / 16.0f)) * (16.0f / 3.0f));
    return l < 31 ? l : 31;
}
typedef float f32x16 __attribute__((ext_vector_type(16)));
constexpr int AT_KSTR = 72, AT_VSTR = 260;
constexpr int AT_TBL = 0, AT_K = 16 * 192 * 4, AT_V = AT_K + 256 * AT_KSTR * 2, AT_END = AT_V + 64 * AT_VSTR * 2;
static_assert(AT_END <= RING_BYTES, "attention LDS");

__device__ __forceinline__ void attn_sub(const LAS bf16_t* Ks, const LAS bf16_t* Vts, const LAS float* tblh, const bf16x8 (&qf)[4], int kb0, int dist0, int kmin, float sink,
                                         bf16_t* orow  , int lane) {
    const int l31 = lane & 31, h = lane >> 5;
    f32x16 s[5];
#pragma unroll
    for (int kt = 0; kt < 5; ++kt) {
        f32x16 acc = {0.f, 0.f, 0.f, 0.f, 0.f, 0.f, 0.f, 0.f, 0.f, 0.f, 0.f, 0.f, 0.f, 0.f, 0.f, 0.f};
        const LAS bf16_t* kp = Ks + (kb0 + kt * 32 + l31) * AT_KSTR + 8 * h;
#pragma unroll
        for (int ds = 0; ds < 4; ++ds) { const bf16x8 a = *(const LAS bf16x8*)(kp + 16 * ds); acc = __builtin_amdgcn_mfma_f32_32x32x16_bf16(a, qf[ds], acc, 0, 0, 0); }
        s[kt] = acc;
    }
    float mx = sink;
#pragma unroll
    for (int kt = 0; kt < 5; ++kt)
#pragma unroll
        for (int r = 0; r < 16; ++r) {
            const int kb = kb0 + kt * 32 + (r & 3) + 8 * (r >> 2) + 4 * h;
            float v = s[kt][r] * 0.125f + tblh[dist0 - kb + 31];
            if (kb < kmin) v = -INFINITY;
            s[kt][r] = v; mx = fmaxf(mx, v);
        }
    mx = fmaxf(mx, __shfl_xor(mx, 32));
    float sum = 0.f;
#pragma unroll
    for (int kt = 0; kt < 5; ++kt)
#pragma unroll
        for (int r = 0; r < 16; ++r) { const float p = __expf(s[kt][r] - mx); s[kt][r] = p; sum += p; }
    sum += __shfl_xor(sum, 32);
    sum += __expf(sink - mx);
    const float inv = 1.0f / sum;
    f32x16 o0 = {0.f, 0.f, 0.f, 0.f, 0.f, 0.f, 0.f, 0.f, 0.f, 0.f, 0.f, 0.f, 0.f, 0.f, 0.f, 0.f}, o1 = o0;
#pragma unroll
    for (int kt = 0; kt < 5; ++kt)
#pragma unroll
        for (int s2 = 0; s2 < 2; ++s2) {
            u32x4 pw; pw.x = pk2(s[kt][8 * s2 + 0], s[kt][8 * s2 + 1]); pw.y = pk2(s[kt][8 * s2 + 2], s[kt][8 * s2 + 3]); pw.z = pk2(s[kt][8 * s2 + 4], s[kt][8 * s2 + 5]); pw.w = pk2(s[kt][8 * s2 + 6], s[kt][8 * s2 + 7]);
            const bf16x8 pb = __builtin_bit_cast(bf16x8, pw);
            const LAS bf16_t* vp = Vts + l31 * AT_VSTR + kb0 + kt * 32 + 16 * s2 + 4 * h;
            { const u32x2 lo = *(const LAS u32x2*)vp, hi = *(const LAS u32x2*)(vp + 8); const u32x4 aw = {lo.x, lo.y, hi.x, hi.y};
              o0 = __builtin_amdgcn_mfma_f32_32x32x16_bf16(__builtin_bit_cast(bf16x8, aw), pb, o0, 0, 0, 0); }
            { const u32x2 lo = *(const LAS u32x2*)(vp + 32 * AT_VSTR), hi = *(const LAS u32x2*)(vp + 32 * AT_VSTR + 8); const u32x4 aw = {lo.x, lo.y, hi.x, hi.y};
              o1 = __builtin_amdgcn_mfma_f32_32x32x16_bf16(__builtin_bit_cast(bf16x8, aw), pb, o1, 0, 0, 0); }
        }
#pragma unroll
    for (int rg = 0; rg < 4; ++rg) {
        u32x2 w0, w1;
        w0.x = pk2(o0[4 * rg] * inv, o0[4 * rg + 1] * inv); w0.y = pk2(o0[4 * rg + 2] * inv, o0[4 * rg + 3] * inv);
        w1.x = pk2(o1[4 * rg] * inv, o1[4 * rg + 1] * inv); w1.y = pk2(o1[4 * rg + 2] * inv, o1[4 * rg + 3] * inv);
        *(u32x2*)(orow + 8 * rg + 4 * h) = w0; *(u32x2*)(orow + 32 + 8 * rg + 4 * h) = w1;
    }
}

__device__ __forceinline__ void phase_attn(const bf16_t* QKV, bf16_t* O, const float* ck, const float* cv, const float* rel_bias, const float* sinks,
                                           float* kS, float* vS, LAS unsigned char* lds, int tid, int wave, int lane) {
    LAS float* tbl = (LAS float*)(lds + AT_TBL);
    LAS bf16_t* Ks = (LAS bf16_t*)(lds + AT_K);
    LAS bf16_t* Vts = (LAS bf16_t*)(lds + AT_V);
    for (int i = tid; i < 16 * 192; i += NTHREADS) { const int hd = i / 192, dist = (i - hd * 192) - 31; tbl[i] = (dist >= 0 && dist < WIN) ? rel_bias[t5_bucket(dist) * NHQ + hd] : -INFINITY; }
    const int l31 = lane & 31, h = lane >> 5;
    for (int u = blockIdx.x; u < 1024; u += gridDim.x) {
        __syncthreads();
        if (u < 512) {
            const int kv = u & 3, qb = (u >> 2) & 15, b = u >> 6;
            const int prow0 = b * PL + qb * 128 - 128;
#pragma unroll
            for (int i = 0; i < 4; ++i) { const int pi = tid + NTHREADS * i, r = pi >> 3, c = pi & 7;
                u32x4 v = {0u, 0u, 0u, 0u};
                if (qb > 0 || r >= 128) v = *(const u32x4*)(QKV + (size_t)(prow0 + r) * QKV_N + KCOL + kv * HD + c * 8);
                *(LAS u32x4*)(Ks + r * AT_KSTR + c * 8) = v; }
#pragma unroll
            for (int i = 0; i < 2; ++i) { const int task = tid + NTHREADS * i, kp = task >> 3, dc = task & 7;
                u32x4 v0 = {0u, 0u, 0u, 0u}, v1 = v0;
                if (qb > 0 || kp >= 64) { const bf16_t* vp = QKV + (size_t)(prow0 + 2 * kp) * QKV_N + VCOL + kv * HD + dc * 8; v0 = *(const u32x4*)vp; v1 = *(const u32x4*)(vp + QKV_N); }
                LAS unsigned* d = (LAS unsigned*)(Vts + (dc * 8) * AT_VSTR + 2 * kp);
                d[0 * (AT_VSTR / 2)] = (v0.x & 0xffffu) | (v1.x << 16); d[1 * (AT_VSTR / 2)] = (v0.x >> 16) | (v1.x & 0xffff0000u);
                d[2 * (AT_VSTR / 2)] = (v0.y & 0xffffu) | (v1.y << 16); d[3 * (AT_VSTR / 2)] = (v0.y >> 16) | (v1.y & 0xffff0000u);
                d[4 * (AT_VSTR / 2)] = (v0.z & 0xffffu) | (v1.z << 16); d[5 * (AT_VSTR / 2)] = (v0.z >> 16) | (v1.z & 0xffff0000u);
                d[6 * (AT_VSTR / 2)] = (v0.w & 0xffffu) | (v1.w << 16); d[7 * (AT_VSTR / 2)] = (v0.w >> 16) | (v1.w & 0xffff0000u); }
            __syncthreads();
            const int g = wave >> 1, qh = wave & 1, head = kv * 4 + g;
            const float sink = sinks[head];
#pragma unroll 1
            for (int sbk = 0; sbk < 2; ++sbk) {
                const int q0 = qh * 64 + sbk * 32;
                const size_t row = (size_t)b * PL + qb * 128 + q0 + l31;
                bf16x8 qf[4];
#pragma unroll
                for (int ds = 0; ds < 4; ++ds) qf[ds] = *(const bf16x8*)(QKV + row * QKV_N + head * HD + 16 * ds + 8 * h);
                attn_sub(Ks, Vts, tbl + head * 192, qf, q0, q0 + l31 + 128, qb == 0 ? 128 : 0, sink, O + row * D + head * HD, lane);
            }
        } else {
            const int us = u - 512, kv = us & 3, b = us >> 2;
            for (int pi = tid; pi < 160 * 8; pi += NTHREADS) { const int r = pi >> 3, c = pi & 7;
                u32x4 kw = {0u, 0u, 0u, 0u}, v0 = kw;
                if (r < WIN) { const size_t src = ((size_t)(b * WIN + r) * NKV + kv) * HD + c * 8;
                    const f32x4 a = *(const f32x4*)(ck + src), a2 = *(const f32x4*)(ck + src + 4), e = *(const f32x4*)(cv + src), e2 = *(const f32x4*)(cv + src + 4);
                    kw.x = pk2(a[0], a[1]); kw.y = pk2(a[2], a[3]); kw.z = pk2(a2[0], a2[1]); kw.w = pk2(a2[2], a2[3]);
                    v0.x = pk2(e[0], e[1]); v0.y = pk2(e[2], e[3]); v0.z = pk2(e2[0], e2[1]); v0.w = pk2(e2[2], e2[3]);
                    if (r >= SL) { const size_t dst = ((size_t)(b * WIN + r - SL) * NKV + kv) * HD + c * 8;
                        *(f32x4*)(kS + dst) = a; *(f32x4*)(kS + dst + 4) = a2; *(f32x4*)(vS + dst) = e; *(f32x4*)(vS + dst + 4) = e2; }
                } else if (r < WIN + SL) { const bf16_t* p = QKV + (size_t)(MP + b * SL + (r - WIN)) * QKV_N + kv * HD + c * 8; kw = *(const u32x4*)(p + KCOL); v0 = *(const u32x4*)(p + VCOL); }
                *(LAS u32x4*)(Ks + r * AT_KSTR + c * 8) = kw;
                LAS bf16_t* d = Vts + (c * 8) * AT_VSTR + r;
                d[0 * AT_VSTR] = (bf16_t)(v0.x & 0xffffu); d[1 * AT_VSTR] = (bf16_t)(v0.x >> 16); d[2 * AT_VSTR] = (bf16_t)(v0.y & 0xffffu); d[3 * AT_VSTR] = (bf16_t)(v0.y >> 16);
                d[4 * AT_VSTR] = (bf16_t)(v0.z & 0xffffu); d[5 * AT_VSTR] = (bf16_t)(v0.z >> 16); d[6 * AT_VSTR] = (bf16_t)(v0.w & 0xffffu); d[7 * AT_VSTR] = (bf16_t)(v0.w >> 16); }
            __syncthreads();
            if (wave == 0) {
                const int g = l31 >> 3, si = l31 & 7, head = kv * 4 + g;
                const size_t row = (size_t)MP + b * SL + si;
                bf16x8 qf[4];
#pragma unroll
                for (int ds = 0; ds < 4; ++ds) qf[ds] = *(const bf16x8*)(QKV + row * QKV_N + head * HD + 16 * ds + 8 * h);
                attn_sub(Ks, Vts, tbl + head * 192, qf, 0, 128 + si, 0, sinks[head], O + row * D + head * HD, lane);
            }
        }
    }
}

constexpr int SS_PT = 136;
constexpr int SS_BRM = 0, SS_CRM = 128 * SS_PT * 2, SS_BT = 2 * 128 * SS_PT * 2, SS_XT = 3 * 128 * SS_PT * 2, SS_H = SS_XT + 64 * SS_PT * 2, SS_F = SS_H + 64 * SS_PT * 2, SS_END = SS_F + 4 * 128 * 4;
static_assert(SS_END <= RING_BYTES, "SSD LDS");

__device__ __forceinline__ void ssd_prompt_unit(KP P, LAS unsigned char* lds, int b, int h, int tid, int wave, int lane) {
    const bf16_t* ZX = (const bf16_t*)(P->ws + WS_ZX); bf16_t* Y = (bf16_t*)(P->ws + WS_Y);
    const float* conv_w = P->in[14]; const float* conv_b = P->in[15];
    LAS bf16_t* Brm = (LAS bf16_t*)(lds + SS_BRM); LAS bf16_t* Crm = (LAS bf16_t*)(lds + SS_CRM); LAS bf16_t* Bt = (LAS bf16_t*)(lds + SS_BT);
    LAS bf16_t* Xt = (LAS bf16_t*)(lds + SS_XT); LAS bf16_t* Hs = (LAS bf16_t*)(lds + SS_H);
    LAS float* dtv = (LAS float*)(lds + SS_F); LAS float* acum = dtv + 128; LAS float* ea = acum + 128; LAS float* dec = ea + 128;
    const int g = h >> 3, l31 = lane & 31, hh = lane >> 5;
    const int tt = wave >> 1, pt = wave & 1;
    const float a = -__expf(P->in[17][h]), dtb = P->in[16][h], Dh = P->in[18][h];
    const size_t row0 = (size_t)b * PL;
    for (int i = tid; i < 64 * SS_PT / 2; i += NTHREADS) ((LAS unsigned*)Hs)[i] = 0u;
    f32x16 hacc = {0.f, 0.f, 0.f, 0.f, 0.f, 0.f, 0.f, 0.f, 0.f, 0.f, 0.f, 0.f, 0.f, 0.f, 0.f, 0.f};
#pragma unroll 1
    for (int c = 0; c < PL / 128; ++c) {
        const size_t rowc = row0 + (size_t)c * 128;
#pragma unroll 1
        for (int k = 0; k < 5; ++k) {
            const int item = tid + NTHREADS * k, seg = item / 320, ch = item - seg * 320;
            const int cc = ch < 64 ? h * 64 + ch : (ch < 192 ? DI + g * 128 + (ch - 64) : DI + 512 + g * 128 + (ch - 192));
            const bf16_t* src = ZX + (rowc + seg * 16) * SSM_INP + XBC_COL + cc;
            float raw[19];
#pragma unroll
            for (int i = 0; i < 19; ++i) raw[i] = (c == 0 && seg == 0 && i < 3) ? 0.f : bf1(src[(ptrdiff_t)(i - 3) * SSM_INP]);
            const float w0 = conv_w[cc], w1 = conv_w[CONV_D + cc], w2 = conv_w[2 * CONV_D + cc], w3 = conv_w[3 * CONV_D + cc], cb = conv_b[cc];
            float o[16];
#pragma unroll
            for (int i = 0; i < 16; ++i) o[i] = silu_f(cb + w0 * raw[i] + w1 * raw[i + 1] + w2 * raw[i + 2] + w3 * raw[i + 3]);
            u32x4 q0, q1;
            q0.x = pk2(o[0], o[1]); q0.y = pk2(o[2], o[3]); q0.z = pk2(o[4], o[5]); q0.w = pk2(o[6], o[7]);
            q1.x = pk2(o[8], o[9]); q1.y = pk2(o[10], o[11]); q1.z = pk2(o[12], o[13]); q1.w = pk2(o[14], o[15]);
            if (ch < 64) { LAS u32x4* d = (LAS u32x4*)(Xt + ch * SS_PT + seg * 16); d[0] = q0; d[1] = q1; }
            else if (ch < 192) { const int n = ch - 64; LAS u32x4* d = (LAS u32x4*)(Bt + n * SS_PT + seg * 16); d[0] = q0; d[1] = q1;
#pragma unroll
                for (int i = 0; i < 16; ++i) Brm[(seg * 16 + i) * SS_PT + n] = (bf16_t)f2bf(o[i]); }
            else { const int n = ch - 192;
#pragma unroll
                for (int i = 0; i < 16; ++i) Crm[(seg * 16 + i) * SS_PT + n] = (bf16_t)f2bf(o[i]); }
        }
        if (wave == 0) {
            const float r0 = bf1(ZX[(rowc + 2 * lane) * SSM_INP + DT_COL + h]) + dtb, r1 = bf1(ZX[(rowc + 2 * lane + 1) * SSM_INP + DT_COL + h]) + dtb;
            const float d0 = r0 > 20.f ? r0 : log1pf(__expf(r0)), d1 = r1 > 20.f ? r1 : log1pf(__expf(r1));
            const float c0 = d0 * a, c1 = c0 + d1 * a;
            float inc = c1;
#pragma unroll
            for (int o2 = 1; o2 < 64; o2 <<= 1) { const float v = __shfl_up(inc, o2); if (lane >= o2) inc += v; }
            const float pre = inc - c1, a0 = pre + c0, a1 = pre + c1;
            const float tot = __shfl(inc, 63);
            dtv[2 * lane] = d0; dtv[2 * lane + 1] = d1; acum[2 * lane] = a0; acum[2 * lane + 1] = a1;
            ea[2 * lane] = __expf(a0); ea[2 * lane + 1] = __expf(a1);
            dec[2 * lane] = __expf(tot - a0) * d0; dec[2 * lane + 1] = __expf(tot - a1) * d1;
        }
        __syncthreads();
        const int tcol = 32 * tt + l31;
        const float acum_t = acum[tcol];
        f32x16 yA = {0.f, 0.f, 0.f, 0.f, 0.f, 0.f, 0.f, 0.f, 0.f, 0.f, 0.f, 0.f, 0.f, 0.f, 0.f, 0.f}, yB = yA;
#pragma unroll 1
        for (int st = 0; st <= tt; ++st) {
            f32x16 gacc = {0.f, 0.f, 0.f, 0.f, 0.f, 0.f, 0.f, 0.f, 0.f, 0.f, 0.f, 0.f, 0.f, 0.f, 0.f, 0.f};
#pragma unroll
            for (int ks = 0; ks < 8; ++ks) {
                const bf16x8 av = *(const LAS bf16x8*)(Brm + (32 * st + l31) * SS_PT + 16 * ks + 8 * hh);
                const bf16x8 bv = *(const LAS bf16x8*)(Crm + tcol * SS_PT + 16 * ks + 8 * hh);
                gacc = __builtin_amdgcn_mfma_f32_32x32x16_bf16(av, bv, gacc, 0, 0, 0);
            }
            float wv[16];
#pragma unroll
            for (int rg = 0; rg < 4; ++rg) {
                const int s0 = 32 * st + 8 * rg + 4 * hh;
                const f32x4 as = *(const LAS f32x4*)(acum + s0), ds = *(const LAS f32x4*)(dtv + s0);
#pragma unroll
                for (int e = 0; e < 4; ++e) { const float v = gacc[4 * rg + e] * __expf(acum_t - as[e]) * ds[e]; wv[4 * rg + e] = (s0 + e <= tcol) ? v : 0.f; }
            }
#pragma unroll
            for (int s2 = 0; s2 < 2; ++s2) {
                u32x4 pw; pw.x = pk2(wv[8 * s2 + 0], wv[8 * s2 + 1]); pw.y = pk2(wv[8 * s2 + 2], wv[8 * s2 + 3]); pw.z = pk2(wv[8 * s2 + 4], wv[8 * s2 + 5]); pw.w = pk2(wv[8 * s2 + 6], wv[8 * s2 + 7]);
                const LAS bf16_t* xp = Xt + (32 * pt + l31) * SS_PT + 32 * st + 16 * s2 + 4 * hh;
                const u32x2 lo = *(const LAS u32x2*)xp, hi = *(const LAS u32x2*)(xp + 8); const u32x4 xw = {lo.x, lo.y, hi.x, hi.y};
                yA = __builtin_amdgcn_mfma_f32_32x32x16_bf16(__builtin_bit_cast(bf16x8, pw), __builtin_bit_cast(bf16x8, xw), yA, 0, 0, 0);
            }
        }
#pragma unroll
        for (int ks = 0; ks < 8; ++ks) {
            const bf16x8 av = *(const LAS bf16x8*)(Crm + tcol * SS_PT + 16 * ks + 8 * hh);
            const bf16x8 bv = *(const LAS bf16x8*)(Hs + (32 * pt + l31) * SS_PT + 16 * ks + 8 * hh);
            yB = __builtin_amdgcn_mfma_f32_32x32x16_bf16(av, bv, yB, 0, 0, 0);
        }
        {
            const int pcol = 32 * pt + l31;
            bf16_t* yo = Y + rowc * DI + h * 64 + pcol;
#pragma unroll
            for (int rg = 0; rg < 4; ++rg) {
                const int t0 = 32 * tt + 8 * rg + 4 * hh;
                const f32x4 ev = *(const LAS f32x4*)(ea + t0);
                const u32x2 xw = *(const LAS u32x2*)(Xt + pcol * SS_PT + t0);
                const float x0 = bflo(xw.x), x1 = bfhi(xw.x), x2 = bflo(xw.y), x3 = bfhi(xw.y);
                yo[(size_t)(t0 + 0) * DI] = (bf16_t)f2bf(yA[4 * rg + 0] + ev[0] * yB[4 * rg + 0] + Dh * x0);
                yo[(size_t)(t0 + 1) * DI] = (bf16_t)f2bf(yA[4 * rg + 1] + ev[1] * yB[4 * rg + 1] + Dh * x1);
                yo[(size_t)(t0 + 2) * DI] = (bf16_t)f2bf(yA[4 * rg + 2] + ev[2] * yB[4 * rg + 2] + Dh * x2);
                yo[(size_t)(t0 + 3) * DI] = (bf16_t)f2bf(yA[4 * rg + 3] + ev[3] * yB[4 * rg + 3] + Dh * x3);
            }
        }
        {
            const float eT = ea[127];
#pragma unroll
            for (int r = 0; r < 16; ++r) hacc[r] *= eT;
#pragma unroll
            for (int ks = 0; ks < 8; ++ks) {
                const bf16x8 av = *(const LAS bf16x8*)(Bt + (32 * tt + l31) * SS_PT + 16 * ks + 8 * hh);
                const u32x4 xw = *(const LAS u32x4*)(Xt + (32 * pt + l31) * SS_PT + 16 * ks + 8 * hh);
                const f32x4 d0 = *(const LAS f32x4*)(dec + 16 * ks + 8 * hh), d1 = *(const LAS f32x4*)(dec + 16 * ks + 8 * hh + 4);
                u32x4 bw; bw.x = pk2(bflo(xw.x) * d0[0], bfhi(xw.x) * d0[1]); bw.y = pk2(bflo(xw.y) * d0[2], bfhi(xw.y) * d0[3]);
                bw.z = pk2(bflo(xw.z) * d1[0], bfhi(xw.z) * d1[1]); bw.w = pk2(bflo(xw.w) * d1[2], bfhi(xw.w) * d1[3]);
                hacc = __builtin_amdgcn_mfma_f32_32x32x16_bf16(av, __builtin_bit_cast(bf16x8, bw), hacc, 0, 0, 0);
            }
        }
        __syncthreads();
#pragma unroll
        for (int rg = 0; rg < 4; ++rg) { u32x2 w; w.x = pk2(hacc[4 * rg], hacc[4 * rg + 1]); w.y = pk2(hacc[4 * rg + 2], hacc[4 * rg + 3]);
            *(LAS u32x2*)(Hs + (32 * pt + l31) * SS_PT + 32 * tt + 8 * rg + 4 * hh) = w; }
    }
    float* ho = P->out + O_SP + (((size_t)b * SH + h) * SP + 32 * pt + l31) * SN + 32 * tt + 4 * hh;
#pragma unroll
    for (int rg = 0; rg < 4; ++rg) *(f32x4*)(ho + 8 * rg) = (f32x4){hacc[4 * rg], hacc[4 * rg + 1], hacc[4 * rg + 2], hacc[4 * rg + 3]};
    __syncthreads();
}

__device__ __forceinline__ void ssd_sample_unit(KP P, LAS unsigned char* lds, int b, int h, int tid) {
    const bf16_t* ZX = (const bf16_t*)(P->ws + WS_ZX); bf16_t* Y = (bf16_t*)(P->ws + WS_Y);
    const float* conv_w = P->in[14]; const float* conv_b = P->in[15]; const float* st_conv = P->in[4]; const float* st_ssm = P->in[5];
    LAS float* xs = (LAS float*)lds;
    LAS float* Bs = xs + SL * 64;
    LAS float* Cs = Bs + SL * 128;
    LAS float* ys = Cs + SL * 128;
    LAS float* dts = ys + SL * 64;
    LAS float* dAs = dts + SL;
    const int p = tid >> 3, nb = tid & 7, g = h >> 3;
    const size_t row0 = (size_t)MP + b * SL;
    const float a = -__expf(P->in[17][h]), dtb = P->in[16][h], Dh = P->in[18][h];
    float hr[16];
    const size_t hoff = (((size_t)b * SH + h) * SP + p) * SN + nb * 16;
#pragma unroll
    for (int i = 0; i < 4; ++i) { const f32x4 v = *(const f32x4*)(st_ssm + hoff + 4 * i); hr[4 * i] = v[0]; hr[4 * i + 1] = v[1]; hr[4 * i + 2] = v[2]; hr[4 * i + 3] = v[3]; }
#pragma unroll
    for (int k = 0; k < 5; ++k) {
        const int idx = tid + NTHREADS * k, t = idx / 320, ch = idx - t * 320;
        const int cc = ch < 64 ? h * 64 + ch : (ch < 192 ? DI + g * 128 + (ch - 64) : DI + 512 + g * 128 + (ch - 192));
        float v = conv_b[cc];
#pragma unroll
        for (int j = 0; j < 4; ++j) {
            const int tt = t - 3 + j;
            const float r = (tt >= 0) ? bf1(ZX[(row0 + tt) * SSM_INP + XBC_COL + cc]) : st_conv[((size_t)b * 3 + (3 + tt)) * CONV_D + cc];
            v += conv_w[j * CONV_D + cc] * r;
        }
        v = silu_f(v);
        if (ch < 64) xs[t * 64 + ch] = v; else if (ch < 192) Bs[t * 128 + (ch - 64)] = v; else Cs[t * 128 + (ch - 192)] = v;
    }
    if (tid < SL) {
        const float raw = bf1(ZX[(row0 + tid) * SSM_INP + DT_COL + h]) + dtb;
        const float dtv = raw > 20.f ? raw : log1pf(__expf(raw));
        dts[tid] = dtv; dAs[tid] = __expf(dtv * a);
    }
    __syncthreads();
#pragma unroll
    for (int t = 0; t < SL; ++t) {
        const float dA = dAs[t], xv = xs[t * 64 + p], xdt = xv * dts[t];
        float acc = 0.f;
#pragma unroll
        for (int i = 0; i < 4; ++i) {
            const f32x4 Bv = *(const LAS f32x4*)(Bs + t * 128 + nb * 16 + 4 * i), Cv = *(const LAS f32x4*)(Cs + t * 128 + nb * 16 + 4 * i);
#pragma unroll
            for (int e = 0; e < 4; ++e) { hr[4 * i + e] = hr[4 * i + e] * dA + xdt * Bv[e]; acc += Cv[e] * hr[4 * i + e]; }
        }
        acc += __shfl_xor(acc, 1); acc += __shfl_xor(acc, 2); acc += __shfl_xor(acc, 4);
        if (nb == 0) ys[t * 64 + p] = acc + Dh * xv;
    }
    float* ho = P->out + O_SS + hoff;
#pragma unroll
    for (int i = 0; i < 4; ++i) *(f32x4*)(ho + 4 * i) = (f32x4){hr[4 * i], hr[4 * i + 1], hr[4 * i + 2], hr[4 * i + 3]};
    __syncthreads();
    if (tid < SL * 32) { const int t = tid >> 5, c2 = (tid & 31) * 2;
        *(unsigned*)(Y + (row0 + t) * DI + h * 64 + c2) = pk2(ys[t * 64 + c2], ys[t * 64 + c2 + 1]); }
    __syncthreads();
}

__device__ __forceinline__ void phase_ssd(KP P, LAS unsigned char* lds, int tid, int wave, int lane) {
    for (int u = blockIdx.x; u < PB * SH; u += gridDim.x) ssd_prompt_unit(P, lds, u >> 5, u & 31, tid, wave, lane);
    for (int u = blockIdx.x; u < SB * SH; u += gridDim.x) ssd_sample_unit(P, lds, u >> 5, u & 31, tid);
}

__device__ __forceinline__ void phase_gnorm(KP P, int gw, int NGW, int lane) {
    const bf16_t* ZX = (const bf16_t*)(P->ws + WS_ZX); bf16_t* Y = (bf16_t*)(P->ws + WS_Y); const float* nw = P->in[19];
    for (int u = gw; u < M * 4; u += NGW) {
        const int row = u >> 2, c = (u & 3) * 512 + lane * 8;
        const u32x4 yw = *(const u32x4*)(Y + (size_t)row * DI + c), zw = *(const u32x4*)(ZX + (size_t)row * SSM_INP + c);
        float v[8];
        v[0] = bflo(yw.x) * silu_f(bflo(zw.x)); v[1] = bfhi(yw.x) * silu_f(bfhi(zw.x)); v[2] = bflo(yw.y) * silu_f(bflo(zw.y)); v[3] = bfhi(yw.y) * silu_f(bfhi(zw.y));
        v[4] = bflo(yw.z) * silu_f(bflo(zw.z)); v[5] = bfhi(yw.z) * silu_f(bfhi(zw.z)); v[6] = bflo(yw.w) * silu_f(bflo(zw.w)); v[7] = bfhi(yw.w) * silu_f(bfhi(zw.w));
        float ss = 0.f;
#pragma unroll
        for (int e = 0; e < 8; ++e) ss += v[e] * v[e];
        const float r = 1.0f / sqrtf(wave_sum(ss) * (1.0f / 512.0f) + RMS_EPS);
        const f32x4 w0 = *(const f32x4*)(nw + c), w1 = *(const f32x4*)(nw + c + 4);
        u32x4 o; o.x = pk2(v[0] * r * w0[0], v[1] * r * w0[1]); o.y = pk2(v[2] * r * w0[2], v[3] * r * w0[3]); o.z = pk2(v[4] * r * w1[0], v[5] * r * w1[1]); o.w = pk2(v[6] * r * w1[2], v[7] * r * w1[3]);
        *(u32x4*)(Y + (size_t)row * DI + c) = o;
    }
}

__device__ __forceinline__ void phase_pooldiff(KP P, int gw, int NGW, int lane) {
    const float* XF = P->out; const float* spool = P->in[6]; bf16_t* DF = (bf16_t*)(P->ws + WS_DIFF);
    const int gt = gw * 64 + lane, NT = NGW * 64;
    for (int i = gt; i < M * 256; i += NT) {
        const int row = i >> 8, c4 = (i & 255) * 4, w = 2 << (c4 >> 8);
        f32x4 s = (f32x4){0.f, 0.f, 0.f, 0.f}; float cnt;
        const f32x4 x = *(const f32x4*)(XF + (size_t)row * D + c4);
        if (row < MP) { const int pos = row & (PL - 1); const int n = (pos + 1) < w ? (pos + 1) : w; cnt = (float)n;
            for (int j = 0; j < n; ++j) s += *(const f32x4*)(XF + (size_t)(row - j) * D + c4); }
        else { const int rs = row - MP, b = rs >> 3, si = rs & 7; cnt = (float)w;
            for (int j = 0; j < w; ++j) { const int r = 15 + si - j;
                s += (r >= 15) ? *(const f32x4*)(XF + (size_t)(MP + b * SL + r - 15) * D + c4) : *(const f32x4*)(spool + ((size_t)b * 15 + r) * D + c4); } }
        const f32x4 d = s / cnt - x;
        u32x2 o; o.x = pk2(d[0], d[1]); o.y = pk2(d[2], d[3]);
        *(u32x2*)(DF + (size_t)row * D + c4) = o;
    }
    for (int i = gt; i < PB * 15 * 256; i += NT) { const int c4 = (i & 255) * 4, r = (i >> 8) % 15, b = (i >> 8) / 15;
        *(f32x4*)(P->out + O_PP + ((size_t)b * 15 + r) * D + c4) = *(const f32x4*)(XF + (size_t)(b * PL + PL - 15 + r) * D + c4); }
    for (int i = gt; i < SB * 15 * 256; i += NT) { const int c4 = (i & 255) * 4, r = (i >> 8) % 15, b = (i >> 8) / 15;
        *(f32x4*)(P->out + O_PS + ((size_t)b * 15 + r) * D + c4) = (r < 7) ? *(const f32x4*)(spool + ((size_t)b * 15 + 8 + r) * D + c4) : *(const f32x4*)(XF + (size_t)(MP + b * SL + r - 7) * D + c4); }
}

typedef GAS unsigned gu32;
#define XB_TMO      128
#define XB_XCNT(j)  (256  + 64 * (j))
#define XB_XSUB(j)  (1280 + 64 * (j))
#define XB_XGEN(j)  (2304 + 64 * (j))
#define XB_TOP      3328
#define XB_TOPGEN   3392
#define XCD_BAR_WORDS 3456
#define XB_SPIN_CAP (1u << 18)
__device__ __forceinline__ unsigned xb_ld(unsigned* p)              { return __hip_atomic_load(p, __ATOMIC_RELAXED, __HIP_MEMORY_SCOPE_AGENT); }
__device__ __forceinline__ unsigned xb_add(unsigned* p, unsigned v) { return __hip_atomic_fetch_add(p, v, __ATOMIC_RELAXED, __HIP_MEMORY_SCOPE_AGENT); }
__device__ __forceinline__ unsigned xb_xcc_id() { return (unsigned)__builtin_amdgcn_s_getreg((3 << 11) | 20) & 0xFu; }
#define XB_SPIN(cond, bar) do { unsigned _sp = 0; while (cond) { __builtin_amdgcn_s_sleep(1); \
    if ((++_sp & 255u) == 0u) { if (xb_ld(&(bar)[XB_TMO])) break; if (_sp > XB_SPIN_CAP) { atomicAdd(&(bar)[XB_TMO], 1u); break; } } } } while (0)
struct XcdBarrier { unsigned* bar; unsigned x; volatile LAS unsigned* st; };
__device__ __forceinline__ XcdBarrier xcd_barrier_post(unsigned* bar, volatile LAS unsigned* st) {
    XcdBarrier b; b.bar = bar; b.x = xb_xcc_id(); b.st = st;
    if (threadIdx.x == 0) (void)xb_add(&bar[XB_XCNT(b.x)], 1u);
    return b;
}
__device__ __forceinline__ void xcd_barrier_complete(unsigned* bar, unsigned x, unsigned& nloc, unsigned& nx) {
    const unsigned G = gridDim.x * gridDim.y * gridDim.z;
    unsigned sum, cnt, mine, sp = 0u;
    for (;;) {
        sum = 0u; cnt = 0u; mine = 0u;
#pragma unroll
        for (unsigned j = 0; j < 16; ++j) { const unsigned c = xb_ld(&bar[XB_XCNT(j)]); sum += c; cnt += (c > 0u) ? 1u : 0u; mine = (j == x) ? c : mine; }
        if (sum == G) break;
        __builtin_amdgcn_s_sleep(1);
        if ((++sp & 255u) == 0u) { if (xb_ld(&bar[XB_TMO])) break; if (sp > XB_SPIN_CAP) { atomicAdd(&bar[XB_TMO], 1u); break; } }
    }
    nloc = mine > 0u ? mine : 1u; nx = cnt > 0u ? cnt : 1u;
}
__device__ __forceinline__ void xcd_barrier(const XcdBarrier& b) {
    asm volatile("s_waitcnt vmcnt(0)" ::: "memory");
    __syncthreads();
    if (threadIdx.x == 0) {
        unsigned* bar = b.bar;
        __builtin_amdgcn_s_waitcnt(0);
        unsigned nloc = b.st[0], nx = b.st[1];
        if (nloc == 0u) { xcd_barrier_complete(bar, b.x, nloc, nx); b.st[0] = nloc; b.st[1] = nx; }
        const unsigned old = xb_add(&bar[XB_XSUB(b.x)], 1u);
        const unsigned gen = old / nloc;
        if (old + 1u == (gen + 1u) * nloc) {
            __builtin_amdgcn_fence(__ATOMIC_RELEASE, "agent");
            asm volatile("s_waitcnt vmcnt(0)" ::: "memory");
            const unsigned og = xb_add(&bar[XB_TOP], 1u);
            const unsigned tg = og / nx;
            if (og + 1u == (tg + 1u) * nx) xb_add(&bar[XB_TOPGEN], 1u);
            else XB_SPIN(xb_ld(&bar[XB_TOPGEN]) == tg, bar);
            __builtin_amdgcn_fence(__ATOMIC_ACQUIRE, "agent");
            xb_add(&bar[XB_XGEN(b.x)], 1u);
            asm volatile("s_waitcnt vmcnt(0)" ::: "memory");
        } else {
            XB_SPIN(xb_ld(&bar[XB_XGEN(b.x)]) == gen, bar);
            __builtin_amdgcn_fence(__ATOMIC_ACQUIRE, "agent");
            asm volatile("s_waitcnt vmcnt(0)" ::: "memory");
        }
    }
    __syncthreads();
}

#ifndef MK_PER_PHASE
#define MK_PER_PHASE 0
#endif
constexpr int N_PHASES = 29;
enum { OP_PREP = 0, OP_GEMM_SIDE, OP_ATTN, OP_GEMM_RES, OP_LN, OP_GEMM_UP, OP_SSD, OP_GNORM, OP_DIFF };

__global__ void __launch_bounds__(NTHREADS, 2) fwd_kernel(Ptrs Parg) {
    extern __shared__ __attribute__((aligned(16))) unsigned char lds_raw[];
    LAS unsigned char* lds = (LAS unsigned char*)lds_raw;
    const int ph_lo = Parg.ph_lo, ph_hi = Parg.ph_hi;
    {
        const int tid0 = threadIdx.x;
        for (int u = tid0; u < (LDS_BYTES - RING_BYTES) / 4; u += NTHREADS) ((LAS unsigned*)(lds + RING_BYTES))[u] = 0u;
        __syncthreads();
        if (ph_hi - ph_lo > 1) { if (tid0 == 0) (void)xb_add(&((unsigned*)(Parg.ws + WS_CTL) + 4096)[XB_XCNT(xb_xcc_id())], 1u); }
    }
    bool probe_rep = false;
    for (int ph = ph_lo; ph < ph_hi; ++ph) {
        int tid = threadIdx.x; asm volatile("" : "+v"(tid));
        KP P = (KP)__builtin_amdgcn_kernarg_segment_ptr(); asm volatile("" : "+s"(P));
        int bx = blockIdx.x; asm volatile("" : "+s"(bx));
        const int lane = tid & 63, wave = __builtin_amdgcn_readfirstlane(tid >> 6);
        const int G = gridDim.x;
        const int vcu = (G % 8 == 0) ? (bx % 8) * (G / 8) + bx / 8 : bx;
        const int gw = vcu * NWAVES + wave, NGW = G * NWAVES;
        unsigned char* ws = P->ws;
        bf16_t* XB = (bf16_t*)(ws + WS_XB);
        float* Z = (float*)(ws + WS_Z);
        float* XF = P->out;
        int op = OP_PREP, L = 0, t = 0;
        if (ph > 0) {
            const int q = ph - 1; int sub;
            if (q < 7) { L = 0; sub = q; } else if (q < 15) { L = 1; sub = q - 7; } else if (q < 21) { L = 2; sub = q - 15; } else { L = 3; sub = q - 21; }
            const int kind = L == 1 ? 1 : (L == 2 ? 2 : 0);
            const int npre = kind == 0 ? 2 : (kind == 1 ? 3 : 1);
            if (sub < npre) { op = kind == 0 ? (sub == 0 ? OP_GEMM_SIDE : OP_ATTN) : (kind == 1 ? (sub == 0 ? OP_GEMM_SIDE : (sub == 1 ? OP_SSD : OP_GNORM)) : OP_DIFF); }
            else { t = sub - npre; op = (t == 0 || t == 3) ? OP_GEMM_RES : ((t == 1 || t == 4) ? OP_LN : OP_GEMM_UP); }
        }
        const int kind = L == 1 ? 1 : (L == 2 ? 2 : 0);
        const int j = L / 3;
#ifndef ONLY_OP
#define ONLY_OP -1
#endif
#define EN(o) (ONLY_OP < 0 || ONLY_OP == (o))
#ifndef PROBE_MASK
#define PROBE_MASK 0
#endif
        if (EN(OP_PREP) && op == OP_PREP) {
            phase_prep(P, lds, gw, NGW, wave, lane);
        } else if (EN(OP_GEMM_SIDE) && op == OP_GEMM_SIDE) {
            pg8::Gemm g; pg8::EpiBf16Side E;
            g.A = XB; g.M = M; g.K = D; g.lda = D; g.ldb = D; g.a_pn_bytes = 0;
            E.out = P->out; E.j = j;
            if (kind == 0) { g.Bt = (const bf16_t*)(ws + WS_WQKV) + (size_t)j * QKV_N * D; g.N = QKV_N; E.O = (bf16_t*)(ws + WS_QKV); E.bias = P->in[9] + j * QKV_N; E.mode = 0; }
            else { g.Bt = (const bf16_t*)(ws + WS_WIN); g.N = SSM_INP; E.O = (bf16_t*)(ws + WS_ZX); E.bias = nullptr; E.mode = 1; }
            pg8::StaticOrder S; S.init(M, g.N, G, bx);
            pg8::gemm_phase<pg8::EpiBf16Side, pg8::StaticOrder, true, true>(lds, g, S, E, tid);
        } else if (EN(OP_ATTN) && op == OP_ATTN) {
            phase_attn((const bf16_t*)(ws + WS_QKV), (bf16_t*)(ws + WS_O), P->in[2] + (size_t)j * SB * WIN * 256, P->in[3] + (size_t)j * SB * WIN * 256, P->in[7], P->in[12] + j * NHQ,
                       P->out + O_KS + (size_t)j * SB * WIN * 256, P->out + O_VS + (size_t)j * SB * WIN * 256, lds, tid, wave, lane);
        } else if (EN(OP_GEMM_RES) && op == OP_GEMM_RES) {
            pg8::Gemm g; pg8::EpiRes E;
            g.M = M; g.N = D; g.a_pn_bytes = 0;
            E.Z = Z; E.bias = nullptr; E.scale = nullptr;
            if (L == 0 && t == 0) { E.baseP = P->in[0]; E.baseS = P->in[1]; } else { E.baseP = XF; E.baseS = XF + (size_t)MP * D; }
            if (t == 3) { g.A = (const bf16_t*)(ws + WS_H); g.lda = FF; g.Bt = (const bf16_t*)(ws + WS_WD) + (size_t)L * D * FF; g.ldb = FF; g.K = FF; }
            else if (kind == 0) { g.A = (const bf16_t*)(ws + WS_O); g.lda = D; g.Bt = (const bf16_t*)(ws + WS_WO) + (size_t)j * D * D; g.ldb = D; g.K = D; E.bias = P->in[11] + j * D; }
            else if (kind == 1) { g.A = (const bf16_t*)(ws + WS_Y); g.lda = DI; g.Bt = (const bf16_t*)(ws + WS_WOUT); g.ldb = DI; g.K = DI; }
            else { g.A = (const bf16_t*)(ws + WS_DIFF); g.lda = D; g.Bt = (const bf16_t*)(ws + WS_WPOOL); g.ldb = 256; g.K = 256; g.a_pn_bytes = 512; E.scale = P->in[22]; }
            pg8::StaticOrder S; S.init(M, D, G, bx);
            pg8::gemm_phase<pg8::EpiRes, pg8::StaticOrder, true, true>(lds, g, S, E, tid);
        } else if (EN(OP_LN) && op == OP_LN) {
            const int which = (t == 1) ? 0 : 1;
            phase_ln(Z, P->in[26] + (size_t)(L * 2 + which) * D, P->in[27] + (size_t)(L * 2 + which) * D, XF, XB, gw, NGW, lane);
        } else if (EN(OP_GEMM_UP) && op == OP_GEMM_UP) {
            pg8::Gemm g; g.A = XB; g.Bt = (const bf16_t*)(ws + WS_WGU) + (size_t)L * GU_N * D; g.M = M; g.N = GU_N; g.K = D; g.lda = D; g.ldb = D; g.a_pn_bytes = 0;
            pg8::EpiSwiGLU E; E.O = (bf16_t*)(ws + WS_H); E.ldc = FF;
            pg8::StaticOrder S; S.init(M, GU_N, G, bx);
            pg8::gemm_phase<pg8::EpiSwiGLU, pg8::StaticOrder, true, true>(lds, g, S, E, tid);
        } else if (EN(OP_SSD) && op == OP_SSD) {
            phase_ssd(P, lds, tid, wave, lane);
        } else if (EN(OP_GNORM) && op == OP_GNORM) {
            phase_gnorm(P, gw, NGW, lane);
        } else if (EN(OP_DIFF) && op == OP_DIFF) {
            phase_pooldiff(P, gw, NGW, lane);
        }
        if (PROBE_MASK) { if (((PROBE_MASK >> op) & 1) && !probe_rep) { probe_rep = true; --ph; } else probe_rep = false; }
        if (ph + 1 < ph_hi) { XcdBarrier bar; bar.bar = (unsigned*)(P->ws + WS_CTL) + 4096; bar.x = xb_xcc_id(); bar.st = (volatile LAS unsigned*)(lds + MISC_OFF) + 8; xcd_barrier(bar); }
    }
}

extern "C" void kernel_launch(void* const* d_in, const int* in_sizes, int n_in, void* d_out, int out_size, void* d_ws, size_t ws_size, hipStream_t stream) {
    static int grid = 0;
    if (grid == 0) {
        if (n_in != 28 || out_size != (int)O_END || ws_size < WS_END) { fprintf(stderr, "kernel_launch: unexpected shapes (n_in %d, out %d, ws %zu)\n", n_in, out_size, ws_size); grid = -1; return; }
        int dev = 0, cus = 0;
        if (hipGetDevice(&dev) != hipSuccess || hipDeviceGetAttribute(&cus, hipDeviceAttributeMultiprocessorCount, dev) != hipSuccess) { grid = -1; return; }
        if (hipFuncSetAttribute((const void*)fwd_kernel, hipFuncAttributeMaxDynamicSharedMemorySize, LDS_BYTES) != hipSuccess) { fprintf(stderr, "kernel_launch: hipFuncSetAttribute failed\n"); grid = -1; return; }
        (void)hipGetLastError();
        grid = cus;
    }
    if (grid < 0) return;
    (void)hipMemsetAsync((char*)d_ws + WS_CTL, 0, CTL_ZERO_BYTES, stream);
    Ptrs a{};
    for (int i = 0; i < 28; ++i) a.in[i] = (const float*)d_in[i];
    a.out = (float*)d_out; a.ws = (unsigned char*)d_ws;
#if MK_PER_PHASE
    for (int ph = 0; ph < N_PHASES; ++ph) { a.ph_lo = ph; a.ph_hi = ph + 1; hipLaunchKernelGGL(fwd_kernel, dim3(grid), dim3(NTHREADS), LDS_BYTES, stream, a); }
#else
    a.ph_lo = 0; a.ph_hi = N_PHASES;
    hipLaunchKernelGGL(fwd_kernel, dim3(grid), dim3(NTHREADS), LDS_BYTES, stream, a);
#endif
}
```

```cpp
#include <hip/hip_runtime.h>
#include <cstdio>
#include <cstdint>

#define LAS __attribute__((address_space(3)))
#define GAS __attribute__((address_space(1)))
typedef unsigned short bf16_t;
typedef short bf16x8 __attribute__((ext_vector_type(8)));
typedef float f32x4 __attribute__((ext_vector_type(4)));
typedef float f32x2 __attribute__((ext_vector_type(2)));
typedef unsigned u32x4 __attribute__((ext_vector_type(4)));
typedef unsigned u32x2 __attribute__((ext_vector_type(2)));

constexpr int D = 1024;
constexpr int PB = 8, PL = 2048, MP = PB * PL;
constexpr int SB = 128, SL = 8, MS = SB * SL;
constexpr int M = MP + MS;
constexpr int NKV = 4, HD = 64, NHQ = 16, WIN = 128;
constexpr int QKV_N = 1536, KCOL = 1024, VCOL = 1280;
constexpr int FF = 2816, GU_N = 2 * FF;
constexpr int DI = 2048, CONV_D = 3072, SSM_IN = 5152, SSM_INP = 5376, SH = 32, SP = 64, SN = 128;
constexpr int XBC_COL = 2048, DT_COL = 5120;
constexpr int DEPTH = 4;
constexpr float LN_EPS = 1e-5f, RMS_EPS = 1e-5f;
constexpr float ALPHA = 1.6817928305074290f;

constexpr size_t O_Y = 0;
constexpr size_t O_KP = (size_t)M * D;
constexpr size_t O_VP = O_KP + (size_t)2 * PB * WIN * 256;
constexpr size_t O_CP = O_VP + (size_t)2 * PB * WIN * 256;
constexpr size_t O_SP = O_CP + (size_t)PB * 3 * CONV_D;
constexpr size_t O_PP = O_SP + (size_t)PB * SH * SP * SN;
constexpr size_t O_KS = O_PP + (size_t)PB * 15 * D;
constexpr size_t O_VS = O_KS + (size_t)2 * SB * WIN * 256;
constexpr size_t O_CS = O_VS + (size_t)2 * SB * WIN * 256;
constexpr size_t O_SS = O_CS + (size_t)SB * 3 * CONV_D;
constexpr size_t O_PS = O_SS + (size_t)SB * SH * SP * SN;
constexpr size_t O_END = O_PS + (size_t)SB * 15 * D;
static_assert(O_END == 74645504, "output size");

constexpr size_t MiB = 1u << 20;
constexpr size_t WS_CTL = 0, CTL_ZERO_BYTES = 1 * MiB;
constexpr size_t WS_WQKV = 1 * MiB;
constexpr size_t WS_WO = WS_WQKV + 6 * MiB;
constexpr size_t WS_WIN = WS_WO + 4 * MiB;
constexpr size_t WS_WOUT = WS_WIN + 11 * MiB;
constexpr size_t WS_WPOOL = WS_WOUT + 4 * MiB;
constexpr size_t WS_WGU = WS_WPOOL + 1 * MiB;
constexpr size_t WS_WD = WS_WGU + 44 * MiB;
constexpr size_t WS_XB = WS_WD + 22 * MiB;
constexpr size_t WS_Z = WS_XB + 34 * MiB;
constexpr size_t WS_BIG = WS_Z + 68 * MiB;
constexpr size_t WS_QKV = WS_BIG;
constexpr size_t WS_O = WS_BIG + 52 * MiB;
constexpr size_t WS_H = WS_BIG;
constexpr size_t WS_ZX = WS_BIG;
constexpr size_t WS_Y = WS_BIG + 180 * MiB;
constexpr size_t WS_DIFF = WS_BIG;
constexpr size_t WS_END = WS_BIG + 250 * MiB;
static_assert(WS_END <= 512 * MiB, "d_ws map");

__device__ __forceinline__ unsigned f2bf(float f) { unsigned u = __builtin_bit_cast(unsigned, f); return (u + 0x7fffu + ((u >> 16) & 1u)) >> 16; }
typedef __bf16 bf16x2_hw __attribute__((ext_vector_type(2)));
__device__ __forceinline__ unsigned pk2(float lo, float hi) { f32x2 v = {lo, hi}; return __builtin_bit_cast(unsigned, __builtin_convertvector(v, bf16x2_hw)); }
__device__ __forceinline__ float bflo(unsigned w) { return __builtin_bit_cast(float, w << 16); }
__device__ __forceinline__ float bfhi(unsigned w) { return __builtin_bit_cast(float, w & 0xffff0000u); }
__device__ __forceinline__ float bf1(bf16_t h) { return __builtin_bit_cast(float, (unsigned)h << 16); }
__device__ __forceinline__ float silu_f(float x) { return x / (1.0f + __expf(-x)); }
__device__ __forceinline__ float wave_sum(float v) {
#pragma unroll
    for (int o = 1; o < 64; o <<= 1) v += __shfl_xor(v, o);
    return v;
}
__device__ __forceinline__ float wave_max(float v) {
#pragma unroll
    for (int o = 1; o < 64; o <<= 1) v = fmaxf(v, __shfl_xor(v, o));
    return v;
}

namespace pg8 {
#define PG8_LAS __attribute__((address_space(3)))
constexpr int BM = 256, BK = 64, HALF = 128, HTB = HALF * BK * 2  , STAGE_BYTES = 8 * HTB, NXCD = 8, WGM = 8;

__host__ __device__ __forceinline__ int lds_byte(int r, int c) { const int st = (r >> 4) * 2 + (c >> 5), rr = r & 15, cc = c & 31, ob = rr * 64 + cc * 2; return st * 1024 + (ob ^ (((ob >> 9) & 1) << 5)); }
__host__ __device__ __forceinline__ void stage_rc(int b, int& R, int& C) { const int st = b / 1024, sb = b % 1024, swz = sb ^ (((sb >> 9) & 1) << 5); R = (st >> 1) * 16 + swz / 64; C = (st & 1) * 32 + (swz % 64) / 2; }
__host__ __device__ __forceinline__ int perm32(int rho) { const int n = rho >> 4, i = rho & 15; return 8 * (i >> 2) + 4 * n + (i & 3); }

struct Unit { int pm, pn; };
struct Gemm { const bf16_t* A; const bf16_t* Bt; int M, N, K, lda, ldb; size_t a_pn_bytes; };

struct StaticOrder {
    int nM, nN, nwg, G, c;
    __host__ __device__ void init(int M_, int N_, int G_, int c_) { nM = M_ / BM; nN = N_ / BM; nwg = nM * nN; G = G_; c = c_; }
    __host__ __device__ bool next(int i, Unit& u) const {
        const long L = (long)i * G + c; if (L >= nwg) return false;
        int wgid = (int)L; { const int q = nwg / NXCD, r = nwg % NXCD, xcd = wgid % NXCD, off = wgid / NXCD; wgid = (xcd < r ? xcd * (q + 1) : r * (q + 1) + (xcd - r) * q) + off; }
        const int nig = WGM * nN, gid = wgid / nig, fm = gid * WGM, gsz = (nM - fm) < WGM ? (nM - fm) : WGM;
        u.pm = fm + ((wgid % nig) % gsz); u.pn = (wgid % nig) / gsz; return true;
    }
    __device__ __forceinline__ void a_ready(const Unit&) const {}
    __device__ __forceinline__ void done(const Unit&) const {}
};


struct EpiBf16Side {
    static constexpr bool PERM = true, AFTER_DRAIN = false;
    bf16_t* O; const float* bias; float* out; int mode, j;
    __device__ __forceinline__ void operator()(const f32x4 (&acc)[2][2][4][2], const Unit& u, int wr, int wc, int fr, int fq) const {
        const int ldc = mode == 0 ? QKV_N : SSM_INP;
        const int side_lo = mode == 0 ? KCOL : XBC_COL, side_hi = mode == 0 ? QKV_N : DT_COL, split = mode == 0 ? VCOL : (1 << 30), side_w = mode == 0 ? 256 : CONV_D;
        const int tailP = mode == 0 ? WIN : 3, rowsP = tailP, tailS = mode == 0 ? SL : 3, rowsS = mode == 0 ? WIN : 3;
        const int colt = u.pn * BM;
        const int c8 = colt + wc * 32 + 8 * fq;
        f32x4 bv[2][2];
#pragma unroll
        for (int bj = 0; bj < 2; ++bj)
#pragma unroll
            for (int n = 0; n < 2; ++n) bv[bj][n] = bias ? *(const f32x4*)(bias + c8 + bj * HALF + 4 * n) : (f32x4){0.f, 0.f, 0.f, 0.f};
        const bool has_side = (colt >= side_lo) && (colt < side_hi);
        const bool second = colt >= split;
        const int corg = second ? split : side_lo;
        float* sideP = out + (mode == 0 ? (second ? O_VP : O_KP) + (size_t)j * PB * WIN * 256 : O_CP);
        float* sideS = out + (mode == 0 ? (second ? O_VS : O_KS) + (size_t)j * SB * WIN * 256 : O_CS);
#pragma unroll
        for (int ai = 0; ai < 2; ++ai)
#pragma unroll
            for (int m = 0; m < 4; ++m) {
                const int row = u.pm * BM + ai * HALF + wr * 64 + m * 16 + fr;
                bf16_t* rowp = O + (size_t)row * ldc + c8;
                float* sp = nullptr;
                if (has_side) {
                    if (row < MP) { const int pos = row & (PL - 1), b = row >> 11; if (pos >= PL - tailP) sp = sideP + ((size_t)b * rowsP + (pos - (PL - tailP))) * side_w; }
                    else { const int rs = row - MP, b = rs >> 3, i = rs & 7; if (i >= SL - tailS) sp = sideS + ((size_t)b * rowsS + (rowsS - tailS) + (i - (SL - tailS))) * side_w; }
                }
#pragma unroll
                for (int bj = 0; bj < 2; ++bj) {
                    const f32x4 v0 = acc[ai][bj][m][0] + bv[bj][0], v1 = acc[ai][bj][m][1] + bv[bj][1];
                    u32x4 w; w.x = pk2(v0[0], v0[1]); w.y = pk2(v0[2], v0[3]); w.z = pk2(v1[0], v1[1]); w.w = pk2(v1[2], v1[3]);
                    *(u32x4*)(rowp + bj * HALF) = w;
                    if (sp) { float* q = sp + (c8 + bj * HALF - corg); *(f32x4*)q = v0; *(f32x4*)(q + 4) = v1; }
                }
                asm volatile("" ::: "memory");
            }
    }
};

struct EpiSwiGLU {
    static constexpr bool PERM = true, AFTER_DRAIN = false;
    bf16_t* O; int ldc;
    __device__ __forceinline__ void operator()(const f32x4 (&acc)[2][2][4][2], const Unit& u, int wr, int wc, int fr, int fq) const {
        const int c8 = u.pn * HALF + wc * 32 + 8 * fq;
#pragma unroll
        for (int ai = 0; ai < 2; ++ai)
#pragma unroll
            for (int m = 0; m < 4; ++m) {
                const int row = u.pm * BM + ai * HALF + wr * 64 + m * 16 + fr;
                const f32x4 g0 = acc[ai][0][m][0], g1 = acc[ai][0][m][1], u0 = acc[ai][1][m][0], u1 = acc[ai][1][m][1];
                u32x4 w;
                w.x = pk2(silu_f(g0[0]) * u0[0], silu_f(g0[1]) * u0[1]); w.y = pk2(silu_f(g0[2]) * u0[2], silu_f(g0[3]) * u0[3]);
                w.z = pk2(silu_f(g1[0]) * u1[0], silu_f(g1[1]) * u1[1]); w.w = pk2(silu_f(g1[2]) * u1[2], silu_f(g1[3]) * u1[3]);
                *(u32x4*)(O + (size_t)row * ldc + c8) = w;
                asm volatile("" ::: "memory");
            }
    }
};

struct EpiRes {
    static constexpr bool PERM = false, AFTER_DRAIN = false;
    float* Z; const float* baseP; const float* baseS; const float* bias; const float* scale;
    __device__ __forceinline__ void operator()(const f32x4 (&acc)[2][2][4][2], const Unit& u, int wr, int wc, int fr, int fq) const {
        const int col0 = u.pn * BM + wc * 32 + 4 * fq;
        f32x4 bv[2][2], sv[2][2];
#pragma unroll
        for (int bj = 0; bj < 2; ++bj)
#pragma unroll
            for (int n = 0; n < 2; ++n) {
                bv[bj][n] = bias ? *(const f32x4*)(bias + col0 + bj * HALF + n * 16) : (f32x4){0.f, 0.f, 0.f, 0.f};
                sv[bj][n] = scale ? *(const f32x4*)(scale + col0 + bj * HALF + n * 16) : (f32x4){1.f, 1.f, 1.f, 1.f};
            }
#pragma unroll
        for (int ai = 0; ai < 2; ++ai)
#pragma unroll
            for (int m = 0; m < 4; ++m) {
                const int row = u.pm * BM + ai * HALF + wr * 64 + m * 16 + fr;
                const float* bp = (row < MP ? baseP + (size_t)row * D : baseS + (size_t)(row - MP) * D) + col0;
                float* zp = Z + (size_t)row * D + col0;
#pragma unroll
                for (int bj = 0; bj < 2; ++bj)
#pragma unroll
                    for (int n = 0; n < 2; ++n) {
                        const f32x4 b = *(const f32x4*)(bp + bj * HALF + n * 16);
                        *(f32x4*)(zp + bj * HALF + n * 16) = b * ALPHA + (acc[ai][bj][m][n] + bv[bj][n]) * sv[bj][n];
                    }
                asm volatile("" ::: "memory");
            }
    }
};

template <class Epi, class Sched, bool ALIGN_EPI = false, bool SP2 = false>
__device__ __forceinline__ void gemm_phase(PG8_LAS unsigned char* lds, const Gemm g, const Sched& S, const Epi& E, const int tid) {
    const int wid = __builtin_amdgcn_readfirstlane(tid >> 6), lane = tid & 63, wr = wid >> 2, wc = wid & 3, fr = lane & 15, fq = lane >> 4;
    const int K = g.K, nt = K / BK, lda = g.lda, ldb = g.ldb;
    unsigned voffA[2], voffB[2];
#pragma unroll
    for (int i = 0; i < 2; ++i) { int R, C; stage_rc(tid * 16 + i * 8192, R, C); const int Rb = Epi::PERM ? ((R & ~31) + perm32(R & 31)) : R;
        voffA[i] = (unsigned)(R * lda + C) * 2u; voffB[i] = (unsigned)(Rb * ldb + C) * 2u; }
    const size_t kstep = (size_t)(BK * 2);
    const size_t hstepA = (size_t)HALF * lda * 2, hstepB = (size_t)HALF * ldb * 2;
    const size_t tstepA = 2 * hstepA, tstepB = 2 * hstepB;
    const size_t apn = g.a_pn_bytes;
    const unsigned ldsw = (unsigned)wid * 1024u;
    const int aoff = lds_byte(wr * 64 + fr, fq * 8), boff = lds_byte(wc * 32 + fr, fq * 8);
#define PG8_SA(b, h) (((b) * 2 + (h)) * HTB)
#define PG8_SB(b, h) ((4 + (b) * 2 + (h)) * HTB)
#define PG8_STAGE(bufoff, gbase, voff) do { _Pragma("unroll") for (int _i = 0; _i < 2; ++_i) \
        __builtin_amdgcn_global_load_lds((const unsigned*)((const char*)(gbase) + (voff)[_i]), (PG8_LAS unsigned*)(lds + (bufoff) + ldsw + _i * 8192), 16, 0, 0); } while (0)
#define PG8_LDA(dst, b, h) do { _Pragma("unroll") for (int m = 0; m < 4; ++m) _Pragma("unroll") for (int k = 0; k < 2; ++k) dst[m][k] = *(const PG8_LAS bf16x8*)(lds + PG8_SA(b, h) + aoff + m * 2048 + k * 1024); } while (0)
#define PG8_LDB(dst, b, h) do { _Pragma("unroll") for (int n = 0; n < 2; ++n) _Pragma("unroll") for (int k = 0; k < 2; ++k) dst[n][k] = *(const PG8_LAS bf16x8*)(lds + PG8_SB(b, h) + boff + n * 2048 + k * 1024); } while (0)
#define PG8_MMA(ai, bj, At, Bt) do { __builtin_amdgcn_s_setprio(1); _Pragma("unroll") for (int m = 0; m < 4; ++m) _Pragma("unroll") for (int n = 0; n < 2; ++n) _Pragma("unroll") for (int k = 0; k < 2; ++k) \
        acc[ai][bj][m][n] = __builtin_amdgcn_mfma_f32_16x16x32_bf16(Bt[n][k], At[m][k], acc[ai][bj][m][n], 0, 0, 0); __builtin_amdgcn_s_setprio(0); } while (0)
#define PG8_WAIT_V(n) asm volatile("s_waitcnt vmcnt(" #n ")" ::: "memory")
#define PG8_WAIT_L(n) asm volatile("s_waitcnt lgkmcnt(" #n ")" ::: "memory")
#define PG8_BAR __builtin_amdgcn_s_barrier()
#define PG8_SCHED __builtin_amdgcn_sched_barrier(0)
    Unit cur, nxt; int ui = 0;
    if (!S.next(0, cur)) return;
    f32x4 acc[2][2][4][2];
#pragma unroll
    for (int a = 0; a < 2; ++a)
#pragma unroll
        for (int b = 0; b < 2; ++b)
#pragma unroll
            for (int m = 0; m < 4; ++m)
#pragma unroll
                for (int n = 0; n < 2; ++n) acc[a][b][m][n] = (f32x4){0.f, 0.f, 0.f, 0.f};
    bf16x8 At[4][2], B0[2][2], B1[2][2];
    const char* cA = (const char*)g.A + (size_t)cur.pm * tstepA + (size_t)cur.pn * apn; const char* cB = (const char*)g.Bt + (size_t)cur.pn * tstepB;
    S.a_ready(cur);
    if constexpr (SP2) {
        PG8_STAGE(PG8_SB(0, 0), cB, voffB); PG8_STAGE(PG8_SB(0, 1), cB + hstepB, voffB); PG8_STAGE(PG8_SA(0, 0), cA, voffA); PG8_STAGE(PG8_SA(0, 1), cA + hstepA, voffA);
        if (wr == 1) PG8_BAR;
        PG8_WAIT_V(2); PG8_BAR;
        PG8_STAGE(PG8_SB(1, 0), cB + kstep, voffB); PG8_STAGE(PG8_SA(1, 0), cA + kstep, voffA); PG8_STAGE(PG8_SB(1, 1), cB + hstepB + kstep, voffB);
        PG8_WAIT_V(6); PG8_BAR;
    } else {
        PG8_STAGE(PG8_SB(0, 0), cB, voffB); PG8_STAGE(PG8_SA(0, 0), cA, voffA); PG8_STAGE(PG8_SB(0, 1), cB + hstepB, voffB); PG8_STAGE(PG8_SA(0, 1), cA + hstepA, voffA);
        if (wr == 1) PG8_BAR;
        PG8_WAIT_V(4); PG8_BAR;
        PG8_STAGE(PG8_SB(1, 0), cB + kstep, voffB); PG8_STAGE(PG8_SA(1, 0), cA + kstep, voffA); PG8_STAGE(PG8_SB(1, 1), cB + hstepB + kstep, voffB);
        PG8_WAIT_V(6); PG8_BAR;
    }
    for (;;) {
        const bool has_next = S.next(ui + 1, nxt);
        const char* nA = has_next ? (const char*)g.A + (size_t)nxt.pm * tstepA + (size_t)nxt.pn * apn : cA; const char* nB = has_next ? (const char*)g.Bt + (size_t)nxt.pn * tstepB : cB;
        for (int t = 0; t < nt; t += 2) {
            const bool last = (t == nt - 2);
            const char* a1 = cA + (size_t)(t + 1) * kstep;
            const char* a2 = last ? nA : cA + (size_t)(t + 2) * kstep; const char* b2 = last ? nB : cB + (size_t)(t + 2) * kstep;
            const char* a3 = a2 + kstep; const char* b3 = b2 + kstep;
            if (last && has_next) S.a_ready(nxt);
            if constexpr (SP2) {
            PG8_LDB(B0, 0, 0); PG8_LDB(B1, 0, 1); PG8_SCHED; PG8_LDA(At, 0, 0); PG8_STAGE(PG8_SA(1, 1), a1 + hstepA, voffA);
            PG8_WAIT_V(8); PG8_WAIT_L(0); PG8_BAR; PG8_MMA(0, 0, At, B0); PG8_MMA(0, 1, At, B1); PG8_BAR; PG8_SCHED;
            PG8_LDA(At, 0, 1); PG8_STAGE(PG8_SB(0, 0), b2, voffB); PG8_STAGE(PG8_SB(0, 1), b2 + hstepB, voffB); PG8_STAGE(PG8_SA(0, 0), a2, voffA);
            PG8_WAIT_V(8); PG8_WAIT_L(0); PG8_BAR; PG8_MMA(1, 0, At, B0); PG8_MMA(1, 1, At, B1); PG8_BAR; PG8_SCHED;
            PG8_LDB(B0, 1, 0); PG8_LDB(B1, 1, 1); PG8_SCHED; PG8_LDA(At, 1, 0); PG8_STAGE(PG8_SA(0, 1), a2 + hstepA, voffA);
            PG8_WAIT_V(8); PG8_WAIT_L(0); PG8_BAR; PG8_MMA(0, 0, At, B0); PG8_MMA(0, 1, At, B1); PG8_BAR; PG8_SCHED;
            PG8_LDA(At, 1, 1); PG8_STAGE(PG8_SB(1, 0), b3, voffB); PG8_STAGE(PG8_SB(1, 1), b3 + hstepB, voffB); PG8_STAGE(PG8_SA(1, 0), a3, voffA);
            PG8_WAIT_V(8); PG8_WAIT_L(0); PG8_BAR; PG8_MMA(1, 0, At, B0); PG8_MMA(1, 1, At, B1); PG8_BAR; PG8_SCHED;
            } else {
            PG8_LDB(B0, 0, 0); PG8_SCHED; PG8_LDA(At, 0, 0); PG8_STAGE(PG8_SA(1, 1), a1 + hstepA, voffA);
            PG8_WAIT_L(8); PG8_BAR; PG8_WAIT_L(0); PG8_MMA(0, 0, At, B0); PG8_BAR; PG8_SCHED;
            PG8_LDB(B1, 0, 1); PG8_STAGE(PG8_SB(0, 0), b2, voffB);
            PG8_BAR; PG8_WAIT_L(0); PG8_MMA(0, 1, At, B1); PG8_BAR;
            PG8_LDA(At, 0, 1); PG8_STAGE(PG8_SA(0, 0), a2, voffA);
            PG8_BAR; PG8_WAIT_L(0); PG8_MMA(1, 0, At, B0); PG8_BAR; PG8_SCHED;
            PG8_STAGE(PG8_SB(0, 1), b2 + hstepB, voffB);
            PG8_WAIT_V(6); PG8_BAR; PG8_MMA(1, 1, At, B1); PG8_BAR;
            PG8_LDB(B0, 1, 0); PG8_SCHED; PG8_LDA(At, 1, 0); PG8_STAGE(PG8_SA(0, 1), a2 + hstepA, voffA);
            PG8_WAIT_L(8); PG8_BAR; PG8_WAIT_L(0); PG8_MMA(0, 0, At, B0); PG8_BAR; PG8_SCHED;
            PG8_LDB(B1, 1, 1); PG8_STAGE(PG8_SB(1, 0), b3, voffB);
            PG8_BAR; PG8_WAIT_L(0); PG8_MMA(0, 1, At, B1); PG8_BAR;
            PG8_LDA(At, 1, 1); PG8_STAGE(PG8_SA(1, 0), a3, voffA);
            PG8_BAR; PG8_WAIT_L(0); PG8_MMA(1, 0, At, B0); PG8_BAR; PG8_SCHED;
            PG8_STAGE(PG8_SB(1, 1), b3 + hstepB, voffB);
            PG8_WAIT_V(6); PG8_BAR; PG8_MMA(1, 1, At, B1); PG8_BAR;
            }
        }
        if constexpr (ALIGN_EPI) { if (wr == 0) PG8_BAR; }
        if constexpr (!Epi::AFTER_DRAIN) { E(acc, cur, wr, wc, fr, fq); S.done(cur); }
        if (!has_next) break;
#pragma unroll
        for (int a = 0; a < 2; ++a)
#pragma unroll
            for (int b = 0; b < 2; ++b)
#pragma unroll
                for (int m = 0; m < 4; ++m)
#pragma unroll
                    for (int n = 0; n < 2; ++n) acc[a][b][m][n] = (f32x4){0.f, 0.f, 0.f, 0.f};
        cur = nxt; cA = nA; cB = nB; ++ui;
        if constexpr (ALIGN_EPI) { if (wr == 1) PG8_BAR; }
    }
    PG8_WAIT_V(0);
    if constexpr (!ALIGN_EPI) { if (wr == 0) PG8_BAR; }
    PG8_BAR;
    if constexpr (Epi::AFTER_DRAIN) { E.fused(acc, cur, wr, wc, fr, fq, lds, wid, lane); S.done(cur); }
#undef PG8_SA
#undef PG8_SB
#undef PG8_STAGE
#undef PG8_LDA
#undef PG8_LDB
#undef PG8_MMA
#undef PG8_WAIT_V
#undef PG8_WAIT_L
#undef PG8_BAR
#undef PG8_SCHED
}
}

constexpr int NWAVES = 8, NTHREADS = NWAVES * 64;
constexpr int RING_BYTES = 147456;
constexpr int MISC_OFF = RING_BYTES + 320;
constexpr int LDS_BYTES = 155648;

struct Ptrs {
    const float* in[28];
    float* out;
    unsigned char* ws;
    int ph_lo, ph_hi;
};
typedef const __attribute__((address_space(4))) Ptrs* KP;

__device__ __forceinline__ void p0_item(const float* W, int N, bf16_t* WT, int ldk, int k0, int n0, int dst_row0, LAS float* scr, int lane) {
#pragma unroll 8
    for (int i = 0; i < 32; ++i) { const int kk = 2 * i + (lane >> 5); scr[kk * 33 + (lane & 31)] = W[(size_t)(k0 + kk) * N + n0 + (lane & 31)]; }
    asm volatile("s_waitcnt lgkmcnt(0)" ::: "memory");
    const int c = lane & 7;
#pragma unroll
    for (int j = 0; j < 4; ++j) { const int n = (lane >> 3) + 8 * j; const LAS float* s = scr + (8 * c) * 33 + n;
        u32x4 o; o.x = pk2(s[0 * 33], s[1 * 33]); o.y = pk2(s[2 * 33], s[3 * 33]); o.z = pk2(s[4 * 33], s[5 * 33]); o.w = pk2(s[6 * 33], s[7 * 33]);
        *(u32x4*)(WT + (size_t)(dst_row0 + n) * ldk + k0 + 8 * c) = o; }
    asm volatile("s_waitcnt lgkmcnt(0)" ::: "memory");
}
__device__ __forceinline__ void p0_mat(const float* W, int K, int N, bf16_t* WT, int mode  , int r, LAS float* scr, int lane) {
    const int nblk = N / 32, kb = r / nblk, nb = r % nblk, k0 = 64 * kb, n0 = 32 * nb;
    int dr = n0;
    if (mode == 1) dr = 256 * (n0 >> 7) + (n0 & 127);
    if (mode == 2) dr = 256 * (n0 >> 7) + 128 + (n0 & 127);
    p0_item(W, N, WT, K, k0, n0, dr, scr, lane);
}
__device__ __forceinline__ void phase_prep(KP P, LAS unsigned char* lds, int gw, int NGW, int wave, int lane) {
    LAS float* scr = (LAS float*)(lds + wave * 16384);
    unsigned char* ws = P->ws;
    constexpr int I_QKV = 16 * 48, I_O = 16 * 32, I_IN = 16 * 161, I_OUT = 32 * 32, I_POOL = 4 * 8, I_G = 16 * 88, I_DN = 44 * 32;
    constexpr int N_ITEMS = 2 * I_QKV + 2 * I_O + I_IN + I_OUT + 4 * I_POOL + 4 * (2 * I_G + I_DN);
    for (int it = gw; it < N_ITEMS; it += NGW) {
        int r = it;
        if (r < 2 * I_QKV) { const int j = r / I_QKV; r -= j * I_QKV; p0_mat(P->in[8] + (size_t)j * D * QKV_N, D, QKV_N, (bf16_t*)(ws + WS_WQKV) + (size_t)j * QKV_N * D, 0, r, scr, lane); continue; } r -= 2 * I_QKV;
        if (r < 2 * I_O) { const int j = r / I_O; r -= j * I_O; p0_mat(P->in[10] + (size_t)j * D * D, D, D, (bf16_t*)(ws + WS_WO) + (size_t)j * D * D, 0, r, scr, lane); continue; } r -= 2 * I_O;
        if (r < I_IN) { p0_mat(P->in[13], D, SSM_IN, (bf16_t*)(ws + WS_WIN), 0, r, scr, lane); continue; } r -= I_IN;
        if (r < I_OUT) { p0_mat(P->in[20], DI, D, (bf16_t*)(ws + WS_WOUT), 0, r, scr, lane); continue; } r -= I_OUT;
        if (r < 4 * I_POOL) { const int g = r / I_POOL; r -= g * I_POOL; p0_mat(P->in[21] + (size_t)g * 256 * 256, 256, 256, (bf16_t*)(ws + WS_WPOOL) + (size_t)g * 256 * 256, 0, r, scr, lane); continue; } r -= 4 * I_POOL;
        { const int per = 2 * I_G + I_DN, i = r / per; r -= i * per;
          if (r < I_G) { p0_mat(P->in[23] + (size_t)i * D * FF, D, FF, (bf16_t*)(ws + WS_WGU) + (size_t)i * GU_N * D, 1, r, scr, lane); continue; } r -= I_G;
          if (r < I_G) { p0_mat(P->in[24] + (size_t)i * D * FF, D, FF, (bf16_t*)(ws + WS_WGU) + (size_t)i * GU_N * D, 2, r, scr, lane); continue; } r -= I_G;
          p0_mat(P->in[25] + (size_t)i * FF * D, FF, D, (bf16_t*)(ws + WS_WD) + (size_t)i * D * FF, 0, r, scr, lane); }
    }
    { const int gt = gw * 64 + lane, NT = NGW * 64; u32x4* z = (u32x4*)((bf16_t*)(ws + WS_WIN) + (size_t)SSM_IN * D);
      for (int i = gt; i < (SSM_INP - SSM_IN) * D / 8; i += NT) z[i] = (u32x4){0u, 0u, 0u, 0u}; }
    { const int gt = gw * 64 + lane, NT = NGW * 64; bf16_t* XB = (bf16_t*)(ws + WS_XB);
      for (int i = gt; i < M * D / 8; i += NT) { const int row = i >> 7, c = (i & 127) * 8;
          const float* src = (row < MP ? P->in[0] + (size_t)row * D : P->in[1] + (size_t)(row - MP) * D) + c;
          const f32x4 a = *(const f32x4*)src, b = *(const f32x4*)(src + 4);
          u32x4 w; w.x = pk2(a[0], a[1]); w.y = pk2(a[2], a[3]); w.z = pk2(b[0], b[1]); w.w = pk2(b[2], b[3]);
          *(u32x4*)(XB + (size_t)row * D + c) = w; } }
}

__device__ __forceinline__ void phase_ln(const float* Z, const float* g, const float* b, float* XF, bf16_t* XB, int gw, int NGW, int lane) {
    f32x4 gv[4], bv[4];
#pragma unroll
    for (int j = 0; j < 4; ++j) { gv[j] = *(const f32x4*)(g + 256 * j + 4 * lane); bv[j] = *(const f32x4*)(b + 256 * j + 4 * lane); }
    for (int row = gw; row < M; row += NGW) {
        const float* zr = Z + (size_t)row * D + 4 * lane;
        f32x4 v[4]; float s = 0.f;
#pragma unroll
        for (int j = 0; j < 4; ++j) { v[j] = *(const f32x4*)(zr + 256 * j); s += (v[j][0] + v[j][1]) + (v[j][2] + v[j][3]); }
        const float mean = wave_sum(s) * (1.f / D); float s2 = 0.f;
#pragma unroll
        for (int j = 0; j < 4; ++j) { v[j] = v[j] - mean; s2 += (v[j][0] * v[j][0] + v[j][1] * v[j][1]) + (v[j][2] * v[j][2] + v[j][3] * v[j][3]); }
        const float rstd = 1.0f / sqrtf(wave_sum(s2) * (1.f / D) + LN_EPS);
        float* xo = XF + (size_t)row * D + 4 * lane; bf16_t* bo = XB + (size_t)row * D + 4 * lane;
#pragma unroll
        for (int j = 0; j < 4; ++j) { const f32x4 o = v[j] * rstd * gv[j] + bv[j]; *(f32x4*)(xo + 256 * j) = o;
            u32x2 w; w.x = pk2(o[0], o[1]); w.y = pk2(o[2], o[3]); *(u32x2*)(bo + 256 * j) = w; }
    }
}

__device__ __forceinline__ int t5_bucket(int n) {
    if (n < 16) return n;
    const int l = 16 + (int)(__log2f((float)n * (1.0f / 16.0f)) * (16.0f / 3.0f));
    return l < 31 ? l : 31;
}
typedef float f32x16 __attribute__((ext_vector_type(16)));
constexpr int AT_KSTR = 72, AT_VSTR = 260;
constexpr int AT_TBL = 0, AT_K = 16 * 192 * 4, AT_V = AT_K + 256 * AT_KSTR * 2, AT_END = AT_V + 64 * AT_VSTR * 2;
static_assert(AT_END <= RING_BYTES, "attention LDS");

__device__ __forceinline__ void attn_sub(const LAS bf16_t* Ks, const LAS bf16_t* Vts, const LAS float* tblh, const bf16x8 (&qf)[4], int kb0, int dist0, int kmin, float sink,
                                         bf16_t* orow  , int lane) {
    const int l31 = lane & 31, h = lane >> 5;
    f32x16 s[5];
#pragma unroll
    for (int kt = 0; kt < 5; ++kt) {
        f32x16 acc = {0.f, 0.f, 0.f, 0.f, 0.f, 0.f, 0.f, 0.f, 0.f, 0.f, 0.f, 0.f, 0.f, 0.f, 0.f, 0.f};
        const LAS bf16_t* kp = Ks + (kb0 + kt * 32 + l31) * AT_KSTR + 8 * h;
#pragma unroll
        for (int ds = 0; ds < 4; ++ds) { const bf16x8 a = *(const LAS bf16x8*)(kp + 16 * ds); acc = __builtin_amdgcn_mfma_f32_32x32x16_bf16(a, qf[ds], acc, 0, 0, 0); }
        s[kt] = acc;
    }
    float mx = sink;
#pragma unroll
    for (int kt = 0; kt < 5; ++kt)
#pragma unroll
        for (int r = 0; r < 16; ++r) {
            const int kb = kb0 + kt * 32 + (r & 3) + 8 * (r >> 2) + 4 * h;
            float v = s[kt][r] * 0.125f + tblh[dist0 - kb + 31];
            if (kb < kmin) v = -INFINITY;
            s[kt][r] = v; mx = fmaxf(mx, v);
        }
    mx = fmaxf(mx, __shfl_xor(mx, 32));
    float sum = 0.f;
#pragma unroll
    for (int kt = 0; kt < 5; ++kt)
#pragma unroll
        for (int r = 0; r < 16; ++r) { const float p = __expf(s[kt][r] - mx); s[kt][r] = p; sum += p; }
    sum += __shfl_xor(sum, 32);
    sum += __expf(sink - mx);
    const float inv = 1.0f / sum;
    f32x16 o0 = {0.f, 0.f, 0.f, 0.f, 0.f, 0.f, 0.f, 0.f, 0.f, 0.f, 0.f, 0.f, 0.f, 0.f, 0.f, 0.f}, o1 = o0;
#pragma unroll
    for (int kt = 0; kt < 5; ++kt)
#pragma unroll
        for (int s2 = 0; s2 < 2; ++s2) {
            u32x4 pw; pw.x = pk2(s[kt][8 * s2 + 0], s[kt][8 * s2 + 1]); pw.y = pk2(s[kt][8 * s2 + 2], s[kt][8 * s2 + 3]); pw.z = pk2(s[kt][8 * s2 + 4], s[kt][8 * s2 + 5]); pw.w = pk2(s[kt][8 * s2 + 6], s[kt][8 * s2 + 7]);
            const bf16x8 pb = __builtin_bit_cast(bf16x8, pw);
            const LAS bf16_t* vp = Vts + l31 * AT_VSTR + kb0 + kt * 32 + 16 * s2 + 4 * h;
            { const u32x2 lo = *(const LAS u32x2*)vp, hi = *(const LAS u32x2*)(vp + 8); const u32x4 aw = {lo.x, lo.y, hi.x, hi.y};
              o0 = __builtin_amdgcn_mfma_f32_32x32x16_bf16(__builtin_bit_cast(bf16x8, aw), pb, o0, 0, 0, 0); }
            { const u32x2 lo = *(const LAS u32x2*)(vp + 32 * AT_VSTR), hi = *(const LAS u32x2*)(vp + 32 * AT_VSTR + 8); const u32x4 aw = {lo.x, lo.y, hi.x, hi.y};
              o1 = __builtin_amdgcn_mfma_f32_32x32x16_bf16(__builtin_bit_cast(bf16x8, aw), pb, o1, 0, 0, 0); }
        }
#pragma unroll
    for (int rg = 0; rg < 4; ++rg) {
        u32x2 w0, w1;
        w0.x = pk2(o0[4 * rg] * inv, o0[4 * rg + 1] * inv); w0.y = pk2(o0[4 * rg + 2] * inv, o0[4 * rg + 3] * inv);
        w1.x = pk2(o1[4 * rg] * inv, o1[4 * rg + 1] * inv); w1.y = pk2(o1[4 * rg + 2] * inv, o1[4 * rg + 3] * inv);
        *(u32x2*)(orow + 8 * rg + 4 * h) = w0; *(u32x2*)(orow + 32 + 8 * rg + 4 * h) = w1;
    }
}

__device__ __forceinline__ void phase_attn(const bf16_t* QKV, bf16_t* O, const float* ck, const float* cv, const float* rel_bias, const float* sinks,
                                           float* kS, float* vS, LAS unsigned char* lds, int tid, int wave, int lane) {
    LAS float* tbl = (LAS float*)(lds + AT_TBL);
    LAS bf16_t* Ks = (LAS bf16_t*)(lds + AT_K);
    LAS bf16_t* Vts = (LAS bf16_t*)(lds + AT_V);
    for (int i = tid; i < 16 * 192; i += NTHREADS) { const int hd = i / 192, dist = (i - hd * 192) - 31; tbl[i] = (dist >= 0 && dist < WIN) ? rel_bias[t5_bucket(dist) * NHQ + hd] : -INFINITY; }
    const int l31 = lane & 31, h = lane >> 5;
    for (int u = blockIdx.x; u < 1024; u += gridDim.x) {
        __syncthreads();
        if (u < 512) {
            const int kv = u & 3, qb = (u >> 2) & 15, b = u >> 6;
            const int prow0 = b * PL + qb * 128 - 128;
#pragma unroll
            for (int i = 0; i < 4; ++i) { const int pi = tid + NTHREADS * i, r = pi >> 3, c = pi & 7;
                u32x4 v = {0u, 0u, 0u, 0u};
                if (qb > 0 || r >= 128) v = *(const u32x4*)(QKV + (size_t)(prow0 + r) * QKV_N + KCOL + kv * HD + c * 8);
                *(LAS u32x4*)(Ks + r * AT_KSTR + c * 8) = v; }
#pragma unroll
            for (int i = 0; i < 2; ++i) { const int task = tid + NTHREADS * i, kp = task >> 3, dc = task & 7;
                u32x4 v0 = {0u, 0u, 0u, 0u}, v1 = v0;
                if (qb > 0 || kp >= 64) { const bf16_t* vp = QKV + (size_t)(prow0 + 2 * kp) * QKV_N + VCOL + kv * HD + dc * 8; v0 = *(const u32x4*)vp; v1 = *(const u32x4*)(vp + QKV_N); }
                LAS unsigned* d = (LAS unsigned*)(Vts + (dc * 8) * AT_VSTR + 2 * kp);
                d[0 * (AT_VSTR / 2)] = (v0.x & 0xffffu) | (v1.x << 16); d[1 * (AT_VSTR / 2)] = (v0.x >> 16) | (v1.x & 0xffff0000u);
                d[2 * (AT_VSTR / 2)] = (v0.y & 0xffffu) | (v1.y << 16); d[3 * (AT_VSTR / 2)] = (v0.y >> 16) | (v1.y & 0xffff0000u);
                d[4 * (AT_VSTR / 2)] = (v0.z & 0xffffu) | (v1.z << 16); d[5 * (AT_VSTR / 2)] = (v0.z >> 16) | (v1.z & 0xffff0000u);
                d[6 * (AT_VSTR / 2)] = (v0.w & 0xffffu) | (v1.w << 16); d[7 * (AT_VSTR / 2)] = (v0.w >> 16) | (v1.w & 0xffff0000u); }
            __syncthreads();
            const int g = wave >> 1, qh = wave & 1, head = kv * 4 + g;
            const float sink = sinks[head];
#pragma unroll 1
            for (int sbk = 0; sbk < 2; ++sbk) {
                const int q0 = qh * 64 + sbk * 32;
                const size_t row = (size_t)b * PL + qb * 128 + q0 + l31;
                bf16x8 qf[4];
#pragma unroll
                for (int ds = 0; ds < 4; ++ds) qf[ds] = *(const bf16x8*)(QKV + row * QKV_N + head * HD + 16 * ds + 8 * h);
                attn_sub(Ks, Vts, tbl + head * 192, qf, q0, q0 + l31 + 128, qb == 0 ? 128 : 0, sink, O + row * D + head * HD, lane);
            }
        } else {
            const int us = u - 512, kv = us & 3, b = us >> 2;
            for (int pi = tid; pi < 160 * 8; pi += NTHREADS) { const int r = pi >> 3, c = pi & 7;
                u32x4 kw = {0u, 0u, 0u, 0u}, v0 = kw;
                if (r < WIN) { const size_t src = ((size_t)(b * WIN + r) * NKV + kv) * HD + c * 8;
                    const f32x4 a = *(const f32x4*)(ck + src), a2 = *(const f32x4*)(ck + src + 4), e = *(const f32x4*)(cv + src), e2 = *(const f32x4*)(cv + src + 4);
                    kw.x = pk2(a[0], a[1]); kw.y = pk2(a[2], a[3]); kw.z = pk2(a2[0], a2[1]); kw.w = pk2(a2[2], a2[3]);
                    v0.x = pk2(e[0], e[1]); v0.y = pk2(e[2], e[3]); v0.z = pk2(e2[0], e2[1]); v0.w = pk2(e2[2], e2[3]);
                    if (r >= SL) { const size_t dst = ((size_t)(b * WIN + r - SL) * NKV + kv) * HD + c * 8;
                        *(f32x4*)(kS + dst) = a; *(f32x4*)(kS + dst + 4) = a2; *(f32x4*)(vS + dst) = e; *(f32x4*)(vS + dst + 4) = e2; }
                } else if (r < WIN + SL) { const bf16_t* p = QKV + (size_t)(MP + b * SL + (r - WIN)) * QKV_N + kv * HD + c * 8; kw = *(const u32x4*)(p + KCOL); v0 = *(const u32x4*)(p + VCOL); }
                *(LAS u32x4*)(Ks + r * AT_KSTR + c * 8) = kw;
                LAS bf16_t* d = Vts + (c * 8) * AT_VSTR + r;
                d[0 * AT_VSTR] = (bf16_t)(v0.x & 0xffffu); d[1 * AT_VSTR] = (bf16_t)(v0.x >> 16); d[2 * AT_VSTR] = (bf16_t)(v0.y & 0xffffu); d[3 * AT_VSTR] = (bf16_t)(v0.y >> 16);
                d[4 * AT_VSTR] = (bf16_t)(v0.z & 0xffffu); d[5 * AT_VSTR] = (bf16_t)(v0.z >> 16); d[6 * AT_VSTR] = (bf16_t)(v0.w & 0xffffu); d[7 * AT_VSTR] = (bf16_t)(v0.w >> 16); }
            __syncthreads();
            if (wave == 0) {
                const int g = l31 >> 3, si = l31 & 7, head = kv * 4 + g;
                const size_t row = (size_t)MP + b * SL + si;
                bf16x8 qf[4];
#pragma unroll
                for (int ds = 0; ds < 4; ++ds) qf[ds] = *(const bf16x8*)(QKV + row * QKV_N + head * HD + 16 * ds + 8 * h);
                attn_sub(Ks, Vts, tbl + head * 192, qf, 0, 128 + si, 0, sinks[head], O + row * D + head * HD, lane);
            }
        }
    }
}

constexpr int SS_PT = 136;
constexpr int SS_BRM = 0, SS_CRM = 128 * SS_PT * 2, SS_BT = 2 * 128 * SS_PT * 2, SS_XT = 3 * 128 * SS_PT * 2, SS_H = SS_XT + 64 * SS_PT * 2, SS_F = SS_H + 64 * SS_PT * 2, SS_END = SS_F + 4 * 128 * 4;
static_assert(SS_END <= RING_BYTES, "SSD LDS");

template <int NS, int HALF, bool ROWS>
__device__ __forceinline__ void conv4(const u32x4 (&raw)[NS + 3], const float* conv_w, const float* conv_b, int cc, LAS bf16_t* rm, unsigned (&qT)[4][NS / 2]) {
    const f32x4 w0 = *(const f32x4*)(conv_w + cc), w1 = *(const f32x4*)(conv_w + CONV_D + cc), w2 = *(const f32x4*)(conv_w + 2 * CONV_D + cc), w3 = *(const f32x4*)(conv_w + 3 * CONV_D + cc), cb = *(const f32x4*)(conv_b + cc);
#define UNPK4(dst, q) do { const unsigned a_ = HALF ? q.z : q.x, b_ = HALF ? q.w : q.y; dst[0] = bflo(a_); dst[1] = bfhi(a_); dst[2] = bflo(b_); dst[3] = bfhi(b_); } while (0)
    f32x4 r0, r1, r2, r3, prev;
    UNPK4(r0, raw[0]); UNPK4(r1, raw[1]); UNPK4(r2, raw[2]);
#pragma unroll
    for (int i = 0; i < NS; ++i) {
        UNPK4(r3, raw[i + 3]);
        f32x4 v = cb + w0 * r0 + w1 * r1 + w2 * r2 + w3 * r3;
        v[0] = silu_f(v[0]); v[1] = silu_f(v[1]); v[2] = silu_f(v[2]); v[3] = silu_f(v[3]);
        r0 = r1; r1 = r2; r2 = r3;
        if (ROWS) { u32x2 q; q.x = pk2(v[0], v[1]); q.y = pk2(v[2], v[3]); *(LAS u32x2*)(rm + i * SS_PT) = q; }
        if (i & 1) { qT[0][i >> 1] = pk2(prev[0], v[0]); qT[1][i >> 1] = pk2(prev[1], v[1]); qT[2][i >> 1] = pk2(prev[2], v[2]); qT[3][i >> 1] = pk2(prev[3], v[3]); } else prev = v;
    }
#undef UNPK4
}
__device__ __forceinline__ void ssd_prompt_unit(KP P, LAS unsigned char* lds, int b, int h, int tid_in, int wave, int lane_in) {
    int tid = tid_in, lane = lane_in;
    const bf16_t* ZX = (const bf16_t*)(P->ws + WS_ZX); bf16_t* Y = (bf16_t*)(P->ws + WS_Y);
    const float* conv_w = P->in[14]; const float* conv_b = P->in[15];
    LAS bf16_t* Brm = (LAS bf16_t*)(lds + SS_BRM); LAS bf16_t* Crm = (LAS bf16_t*)(lds + SS_CRM); LAS bf16_t* Bt = (LAS bf16_t*)(lds + SS_BT);
    LAS bf16_t* Xt = (LAS bf16_t*)(lds + SS_XT); LAS bf16_t* Hs = (LAS bf16_t*)(lds + SS_H);
    LAS float* dtv = (LAS float*)(lds + SS_F); LAS float* acum = dtv + 128; LAS float* ea = acum + 128; LAS float* dec = ea + 128;
    const int g = h >> 3;
    const int tt = wave >> 1, pt = wave & 1;
    const float a = -__expf(P->in[17][h]), dtb = P->in[16][h], Dh = P->in[18][h];
    const size_t row0 = (size_t)b * PL;
    for (int i = tid; i < 64 * SS_PT / 2; i += NTHREADS) ((LAS unsigned*)Hs)[i] = 0u;
    f32x16 hacc = {0.f, 0.f, 0.f, 0.f, 0.f, 0.f, 0.f, 0.f, 0.f, 0.f, 0.f, 0.f, 0.f, 0.f, 0.f, 0.f};
#pragma unroll 1
    for (int c = 0; c < PL / 128; ++c) {
        const size_t rowc = row0 + (size_t)c * 128;
        asm volatile("" : "+v"(tid), "+v"(lane));
        const int l31 = lane & 31, hh = lane >> 5;
        {
            const int cg = tid & 31, seg = tid >> 5, isC = cg >> 4, n0 = (cg & 15) * 8;
            const int cc = DI + isC * 512 + g * 128 + n0;
            const bf16_t* src = ZX + (rowc + seg * 8) * SSM_INP + XBC_COL + cc;
            const int xcg = tid & 7, xs2 = tid >> 3, p0 = xcg * 8;
            const int xcc = h * 64 + p0;
            const bf16_t* xsrc = ZX + (rowc + xs2 * 2) * SSM_INP + XBC_COL + xcc;
            u32x4 raw[11], xraw[5];
#pragma unroll
            for (int i = 0; i < 11; ++i) raw[i] = (c == 0 && seg == 0 && i < 3) ? (u32x4){0u, 0u, 0u, 0u} : *(const u32x4*)(src + (ptrdiff_t)(i - 3) * SSM_INP);
#pragma unroll
            for (int i = 0; i < 5; ++i) xraw[i] = (c == 0 && xs2 * 2 - 3 + i < 0) ? (u32x4){0u, 0u, 0u, 0u} : *(const u32x4*)(xsrc + (ptrdiff_t)(i - 3) * SSM_INP);
            LAS bf16_t* rm = (isC ? Crm : Brm) + (seg * 8) * SS_PT + n0;
            unsigned qT[4][4];
            conv4<8, 0, true>(raw, conv_w, conv_b, cc, rm, qT);
            if (!isC) {
#pragma unroll
                for (int j = 0; j < 4; ++j) *(LAS u32x4*)(Bt + (n0 + j) * SS_PT + seg * 8) = (u32x4){qT[j][0], qT[j][1], qT[j][2], qT[j][3]};
            }
            __builtin_amdgcn_sched_barrier(0);
            conv4<8, 1, true>(raw, conv_w, conv_b, cc + 4, rm + 4, qT);
            if (!isC) {
#pragma unroll
                for (int j = 0; j < 4; ++j) *(LAS u32x4*)(Bt + (n0 + 4 + j) * SS_PT + seg * 8) = (u32x4){qT[j][0], qT[j][1], qT[j][2], qT[j][3]};
            }
            __builtin_amdgcn_sched_barrier(0);
            unsigned qx[4][1];
            conv4<2, 0, false>(xraw, conv_w, conv_b, xcc, nullptr, qx);
#pragma unroll
            for (int j = 0; j < 4; ++j) *(LAS unsigned*)(Xt + (p0 + j) * SS_PT + xs2 * 2) = qx[j][0];
            conv4<2, 1, false>(xraw, conv_w, conv_b, xcc + 4, nullptr, qx);
#pragma unroll
            for (int j = 0; j < 4; ++j) *(LAS unsigned*)(Xt + (p0 + 4 + j) * SS_PT + xs2 * 2) = qx[j][0];
        }
        if (wave == 0) {
            const float r0 = bf1(ZX[(rowc + 2 * lane) * SSM_INP + DT_COL + h]) + dtb, r1 = bf1(ZX[(rowc + 2 * lane + 1) * SSM_INP + DT_COL + h]) + dtb;
            const float d0 = r0 > 20.f ? r0 : log1pf(__expf(r0)), d1 = r1 > 20.f ? r1 : log1pf(__expf(r1));
            const float c0 = d0 * a, c1 = c0 + d1 * a;
            float inc = c1;
#pragma unroll
            for (int o2 = 1; o2 < 64; o2 <<= 1) { const float v = __shfl_up(inc, o2); if (lane >= o2) inc += v; }
            const float pre = inc - c1, a0 = pre + c0, a1 = pre + c1;
            const float tot = __shfl(inc, 63);
            dtv[2 * lane] = d0; dtv[2 * lane + 1] = d1; acum[2 * lane] = a0; acum[2 * lane + 1] = a1;
            ea[2 * lane] = __expf(a0); ea[2 * lane + 1] = __expf(a1);
            dec[2 * lane] = __expf(tot - a0) * d0; dec[2 * lane + 1] = __expf(tot - a1) * d1;
        }
        __syncthreads();
        const int tcol = 32 * tt + l31;
        const float acum_t = acum[tcol];
        f32x16 yA = {0.f, 0.f, 0.f, 0.f, 0.f, 0.f, 0.f, 0.f, 0.f, 0.f, 0.f, 0.f, 0.f, 0.f, 0.f, 0.f}, yB = yA;
#pragma unroll 1
        for (int st = 0; st <= tt; ++st) {
            f32x16 gacc = {0.f, 0.f, 0.f, 0.f, 0.f, 0.f, 0.f, 0.f, 0.f, 0.f, 0.f, 0.f, 0.f, 0.f, 0.f, 0.f};
#pragma unroll
            for (int ks = 0; ks < 8; ++ks) {
                const bf16x8 av = *(const LAS bf16x8*)(Brm + (32 * st + l31) * SS_PT + 16 * ks + 8 * hh);
                const bf16x8 bv = *(const LAS bf16x8*)(Crm + tcol * SS_PT + 16 * ks + 8 * hh);
                gacc = __builtin_amdgcn_mfma_f32_32x32x16_bf16(av, bv, gacc, 0, 0, 0);
            }
            float wv[16];
#pragma unroll
            for (int rg = 0; rg < 4; ++rg) {
                const int s0 = 32 * st + 8 * rg + 4 * hh;
                const f32x4 as = *(const LAS f32x4*)(acum + s0), ds = *(const LAS f32x4*)(dtv + s0);
#pragma unroll
                for (int e = 0; e < 4; ++e) { const float v = gacc[4 * rg + e] * __expf(acum_t - as[e]) * ds[e]; wv[4 * rg + e] = (s0 + e <= tcol) ? v : 0.f; }
            }
#pragma unroll
            for (int s2 = 0; s2 < 2; ++s2) {
                u32x4 pw; pw.x = pk2(wv[8 * s2 + 0], wv[8 * s2 + 1]); pw.y = pk2(wv[8 * s2 + 2], wv[8 * s2 + 3]); pw.z = pk2(wv[8 * s2 + 4], wv[8 * s2 + 5]); pw.w = pk2(wv[8 * s2 + 6], wv[8 * s2 + 7]);
                const LAS bf16_t* xp = Xt + (32 * pt + l31) * SS_PT + 32 * st + 16 * s2 + 4 * hh;
                const u32x2 lo = *(const LAS u32x2*)xp, hi = *(const LAS u32x2*)(xp + 8); const u32x4 xw = {lo.x, lo.y, hi.x, hi.y};
                yA = __builtin_amdgcn_mfma_f32_32x32x16_bf16(__builtin_bit_cast(bf16x8, pw), __builtin_bit_cast(bf16x8, xw), yA, 0, 0, 0);
            }
        }
#pragma unroll
        for (int ks = 0; ks < 8; ++ks) {
            const bf16x8 av = *(const LAS bf16x8*)(Crm + tcol * SS_PT + 16 * ks + 8 * hh);
            const bf16x8 bv = *(const LAS bf16x8*)(Hs + (32 * pt + l31) * SS_PT + 16 * ks + 8 * hh);
            yB = __builtin_amdgcn_mfma_f32_32x32x16_bf16(av, bv, yB, 0, 0, 0);
        }
        {
            const int pcol = 32 * pt + l31;
            bf16_t* yo = Y + rowc * DI + h * 64 + pcol;
#pragma unroll
            for (int rg = 0; rg < 4; ++rg) {
                const int t0 = 32 * tt + 8 * rg + 4 * hh;
                const f32x4 ev = *(const LAS f32x4*)(ea + t0);
                const u32x2 xw = *(const LAS u32x2*)(Xt + pcol * SS_PT + t0);
                const float x0 = bflo(xw.x), x1 = bfhi(xw.x), x2 = bflo(xw.y), x3 = bfhi(xw.y);
                yo[(size_t)(t0 + 0) * DI] = (bf16_t)f2bf(yA[4 * rg + 0] + ev[0] * yB[4 * rg + 0] + Dh * x0);
                yo[(size_t)(t0 + 1) * DI] = (bf16_t)f2bf(yA[4 * rg + 1] + ev[1] * yB[4 * rg + 1] + Dh * x1);
                yo[(size_t)(t0 + 2) * DI] = (bf16_t)f2bf(yA[4 * rg + 2] + ev[2] * yB[4 * rg + 2] + Dh * x2);
                yo[(size_t)(t0 + 3) * DI] = (bf16_t)f2bf(yA[4 * rg + 3] + ev[3] * yB[4 * rg + 3] + Dh * x3);
            }
        }
        {
            const float eT = ea[127];
#pragma unroll
            for (int r = 0; r < 16; ++r) hacc[r] *= eT;
#pragma unroll
            for (int ks = 0; ks < 8; ++ks) {
                const bf16x8 av = *(const LAS bf16x8*)(Bt + (32 * tt + l31) * SS_PT + 16 * ks + 8 * hh);
                const u32x4 xw = *(const LAS u32x4*)(Xt + (32 * pt + l31) * SS_PT + 16 * ks + 8 * hh);
                const f32x4 d0 = *(const LAS f32x4*)(dec + 16 * ks + 8 * hh), d1 = *(const LAS f32x4*)(dec + 16 * ks + 8 * hh + 4);
                u32x4 bw; bw.x = pk2(bflo(xw.x) * d0[0], bfhi(xw.x) * d0[1]); bw.y = pk2(bflo(xw.y) * d0[2], bfhi(xw.y) * d0[3]);
                bw.z = pk2(bflo(xw.z) * d1[0], bfhi(xw.z) * d1[1]); bw.w = pk2(bflo(xw.w) * d1[2], bfhi(xw.w) * d1[3]);
                hacc = __builtin_amdgcn_mfma_f32_32x32x16_bf16(av, __builtin_bit_cast(bf16x8, bw), hacc, 0, 0, 0);
            }
        }
        __syncthreads();
#pragma unroll
        for (int rg = 0; rg < 4; ++rg) { u32x2 w; w.x = pk2(hacc[4 * rg], hacc[4 * rg + 1]); w.y = pk2(hacc[4 * rg + 2], hacc[4 * rg + 3]);
            *(LAS u32x2*)(Hs + (32 * pt + l31) * SS_PT + 32 * tt + 8 * rg + 4 * hh) = w; }
    }
    const int l31 = lane & 31, hh = lane >> 5;
    float* ho = P->out + O_SP + (((size_t)b * SH + h) * SP + 32 * pt + l31) * SN + 32 * tt + 4 * hh;
#pragma unroll
    for (int rg = 0; rg < 4; ++rg) *(f32x4*)(ho + 8 * rg) = (f32x4){hacc[4 * rg], hacc[4 * rg + 1], hacc[4 * rg + 2], hacc[4 * rg + 3]};
    __syncthreads();
}

__device__ __forceinline__ void ssd_sample_unit(KP P, LAS unsigned char* lds, int b, int h, int tid) {
    const bf16_t* ZX = (const bf16_t*)(P->ws + WS_ZX); bf16_t* Y = (bf16_t*)(P->ws + WS_Y);
    const float* conv_w = P->in[14]; const float* conv_b = P->in[15]; const float* st_conv = P->in[4]; const float* st_ssm = P->in[5];
    LAS float* xs = (LAS float*)lds;
    LAS float* Bs = xs + SL * 64;
    LAS float* Cs = Bs + SL * 128;
    LAS float* ys = Cs + SL * 128;
    LAS float* dts = ys + SL * 64;
    LAS float* dAs = dts + SL;
    const int p = tid >> 3, nb = tid & 7, g = h >> 3;
    const size_t row0 = (size_t)MP + b * SL;
    const float a = -__expf(P->in[17][h]), dtb = P->in[16][h], Dh = P->in[18][h];
    float hr[16];
    const size_t hoff = (((size_t)b * SH + h) * SP + p) * SN + nb * 16;
#pragma unroll
    for (int i = 0; i < 4; ++i) { const f32x4 v = *(const f32x4*)(st_ssm + hoff + 4 * i); hr[4 * i] = v[0]; hr[4 * i + 1] = v[1]; hr[4 * i + 2] = v[2]; hr[4 * i + 3] = v[3]; }
#pragma unroll
    for (int k = 0; k < 5; ++k) {
        const int idx = tid + NTHREADS * k, t = idx / 320, ch = idx - t * 320;
        const int cc = ch < 64 ? h * 64 + ch : (ch < 192 ? DI + g * 128 + (ch - 64) : DI + 512 + g * 128 + (ch - 192));
        float v = conv_b[cc];
#pragma unroll
        for (int j = 0; j < 4; ++j) {
            const int tt = t - 3 + j;
            const float r = (tt >= 0) ? bf1(ZX[(row0 + tt) * SSM_INP + XBC_COL + cc]) : st_conv[((size_t)b * 3 + (3 + tt)) * CONV_D + cc];
            v += conv_w[j * CONV_D + cc] * r;
        }
        v = silu_f(v);
        if (ch < 64) xs[t * 64 + ch] = v; else if (ch < 192) Bs[t * 128 + (ch - 64)] = v; else Cs[t * 128 + (ch - 192)] = v;
    }
    if (tid < SL) {
        const float raw = bf1(ZX[(row0 + tid) * SSM_INP + DT_COL + h]) + dtb;
        const float dtv = raw > 20.f ? raw : log1pf(__expf(raw));
        dts[tid] = dtv; dAs[tid] = __expf(dtv * a);
    }
    __syncthreads();
#pragma unroll
    for (int t = 0; t < SL; ++t) {
        const float dA = dAs[t], xv = xs[t * 64 + p], xdt = xv * dts[t];
        float acc = 0.f;
#pragma unroll
        for (int i = 0; i < 4; ++i) {
            const f32x4 Bv = *(const LAS f32x4*)(Bs + t * 128 + nb * 16 + 4 * i), Cv = *(const LAS f32x4*)(Cs + t * 128 + nb * 16 + 4 * i);
#pragma unroll
            for (int e = 0; e < 4; ++e) { hr[4 * i + e] = hr[4 * i + e] * dA + xdt * Bv[e]; acc += Cv[e] * hr[4 * i + e]; }
        }
        acc += __shfl_xor(acc, 1); acc += __shfl_xor(acc, 2); acc += __shfl_xor(acc, 4);
        if (nb == 0) ys[t * 64 + p] = acc + Dh * xv;
    }
    float* ho = P->out + O_SS + hoff;
#pragma unroll
    for (int i = 0; i < 4; ++i) *(f32x4*)(ho + 4 * i) = (f32x4){hr[4 * i], hr[4 * i + 1], hr[4 * i + 2], hr[4 * i + 3]};
    __syncthreads();
    if (tid < SL * 32) { const int t = tid >> 5, c2 = (tid & 31) * 2;
        *(unsigned*)(Y + (row0 + t) * DI + h * 64 + c2) = pk2(ys[t * 64 + c2], ys[t * 64 + c2 + 1]); }
    __syncthreads();
}

__device__ __forceinline__ void phase_ssd(KP P, LAS unsigned char* lds, int tid, int wave, int lane) {
    for (int u = blockIdx.x; u < PB * SH; u += gridDim.x) ssd_prompt_unit(P, lds, u >> 5, u & 31, tid, wave, lane);
    for (int u = blockIdx.x; u < SB * SH; u += gridDim.x) ssd_sample_unit(P, lds, u >> 5, u & 31, tid);
}

__device__ __forceinline__ void phase_gnorm(KP P, int gw, int NGW, int lane) {
    const bf16_t* ZX = (const bf16_t*)(P->ws + WS_ZX); bf16_t* Y = (bf16_t*)(P->ws + WS_Y); const float* nw = P->in[19];
    for (int u = gw; u < M * 4; u += NGW) {
        const int row = u >> 2, c = (u & 3) * 512 + lane * 8;
        const u32x4 yw = *(const u32x4*)(Y + (size_t)row * DI + c), zw = *(const u32x4*)(ZX + (size_t)row * SSM_INP + c);
        float v[8];
        v[0] = bflo(yw.x) * silu_f(bflo(zw.x)); v[1] = bfhi(yw.x) * silu_f(bfhi(zw.x)); v[2] = bflo(yw.y) * silu_f(bflo(zw.y)); v[3] = bfhi(yw.y) * silu_f(bfhi(zw.y));
        v[4] = bflo(yw.z) * silu_f(bflo(zw.z)); v[5] = bfhi(yw.z) * silu_f(bfhi(zw.z)); v[6] = bflo(yw.w) * silu_f(bflo(zw.w)); v[7] = bfhi(yw.w) * silu_f(bfhi(zw.w));
        float ss = 0.f;
#pragma unroll
        for (int e = 0; e < 8; ++e) ss += v[e] * v[e];
        const float r = 1.0f / sqrtf(wave_sum(ss) * (1.0f / 512.0f) + RMS_EPS);
        const f32x4 w0 = *(const f32x4*)(nw + c), w1 = *(const f32x4*)(nw + c + 4);
        u32x4 o; o.x = pk2(v[0] * r * w0[0], v[1] * r * w0[1]); o.y = pk2(v[2] * r * w0[2], v[3] * r * w0[3]); o.z = pk2(v[4] * r * w1[0], v[5] * r * w1[1]); o.w = pk2(v[6] * r * w1[2], v[7] * r * w1[3]);
        *(u32x4*)(Y + (size_t)row * DI + c) = o;
    }
}

__device__ __forceinline__ void phase_pooldiff(KP P, int gw, int NGW, int lane) {
    const float* XF = P->out; const float* spool = P->in[6]; bf16_t* DF = (bf16_t*)(P->ws + WS_DIFF);
    const int gt = gw * 64 + lane, NT = NGW * 64;
    for (int i = gt; i < M * 256; i += NT) {
        const int row = i >> 8, c4 = (i & 255) * 4, w = 2 << (c4 >> 8);
        f32x4 s = (f32x4){0.f, 0.f, 0.f, 0.f}; float cnt;
        const f32x4 x = *(const f32x4*)(XF + (size_t)row * D + c4);
        if (row < MP) { const int pos = row & (PL - 1); const int n = (pos + 1) < w ? (pos + 1) : w; cnt = (float)n;
            for (int j = 0; j < n; ++j) s += *(const f32x4*)(XF + (size_t)(row - j) * D + c4); }
        else { const int rs = row - MP, b = rs >> 3, si = rs & 7; cnt = (float)w;
            for (int j = 0; j < w; ++j) { const int r = 15 + si - j;
                s += (r >= 15) ? *(const f32x4*)(XF + (size_t)(MP + b * SL + r - 15) * D + c4) : *(const f32x4*)(spool + ((size_t)b * 15 + r) * D + c4); } }
        const f32x4 d = s / cnt - x;
        u32x2 o; o.x = pk2(d[0], d[1]); o.y = pk2(d[2], d[3]);
        *(u32x2*)(DF + (size_t)row * D + c4) = o;
    }
    for (int i = gt; i < PB * 15 * 256; i += NT) { const int c4 = (i & 255) * 4, r = (i >> 8) % 15, b = (i >> 8) / 15;
        *(f32x4*)(P->out + O_PP + ((size_t)b * 15 + r) * D + c4) = *(const f32x4*)(XF + (size_t)(b * PL + PL - 15 + r) * D + c4); }
    for (int i = gt; i < SB * 15 * 256; i += NT) { const int c4 = (i & 255) * 4, r = (i >> 8) % 15, b = (i >> 8) / 15;
        *(f32x4*)(P->out + O_PS + ((size_t)b * 15 + r) * D + c4) = (r < 7) ? *(const f32x4*)(spool + ((size_t)b * 15 + 8 + r) * D + c4) : *(const f32x4*)(XF + (size_t)(MP + b * SL + r - 7) * D + c4); }
}

typedef GAS unsigned gu32;
#define XB_TMO      128
#define XB_XCNT(j)  (256  + 64 * (j))
#define XB_XSUB(j)  (1280 + 64 * (j))
#define XB_XGEN(j)  (2304 + 64 * (j))
#define XB_TOP      3328
#define XB_TOPGEN   3392
#define XCD_BAR_WORDS 3456
#define XB_SPIN_CAP (1u << 18)
__device__ __forceinline__ unsigned xb_ld(unsigned* p)              { return __hip_atomic_load(p, __ATOMIC_RELAXED, __HIP_MEMORY_SCOPE_AGENT); }
__device__ __forceinline__ unsigned xb_add(unsigned* p, unsigned v) { return __hip_atomic_fetch_add(p, v, __ATOMIC_RELAXED, __HIP_MEMORY_SCOPE_AGENT); }
__device__ __forceinline__ unsigned xb_xcc_id() { return (unsigned)__builtin_amdgcn_s_getreg((3 << 11) | 20) & 0xFu; }
#define XB_SPIN(cond, bar) do { unsigned _sp = 0; while (cond) { __builtin_amdgcn_s_sleep(1); \
    if ((++_sp & 255u) == 0u) { if (xb_ld(&(bar)[XB_TMO])) break; if (_sp > XB_SPIN_CAP) { atomicAdd(&(bar)[XB_TMO], 1u); break; } } } } while (0)
struct XcdBarrier { unsigned* bar; unsigned x; volatile LAS unsigned* st; };
__device__ __forceinline__ XcdBarrier xcd_barrier_post(unsigned* bar, volatile LAS unsigned* st) {
    XcdBarrier b; b.bar = bar; b.x = xb_xcc_id(); b.st = st;
    if (threadIdx.x == 0) (void)xb_add(&bar[XB_XCNT(b.x)], 1u);
    return b;
}
__device__ __forceinline__ void xcd_barrier_complete(unsigned* bar, unsigned x, unsigned& nloc, unsigned& nx) {
    const unsigned G = gridDim.x * gridDim.y * gridDim.z;
    unsigned sum, cnt, mine, sp = 0u;
    for (;;) {
        sum = 0u; cnt = 0u; mine = 0u;
#pragma unroll
        for (unsigned j = 0; j < 16; ++j) { const unsigned c = xb_ld(&bar[XB_XCNT(j)]); sum += c; cnt += (c > 0u) ? 1u : 0u; mine = (j == x) ? c : mine; }
        if (sum == G) break;
        __builtin_amdgcn_s_sleep(1);
        if ((++sp & 255u) == 0u) { if (xb_ld(&bar[XB_TMO])) break; if (sp > XB_SPIN_CAP) { atomicAdd(&bar[XB_TMO], 1u); break; } }
    }
    nloc = mine > 0u ? mine : 1u; nx = cnt > 0u ? cnt : 1u;
}
__device__ __forceinline__ void xcd_barrier(const XcdBarrier& b) {
    asm volatile("s_waitcnt vmcnt(0)" ::: "memory");
    __syncthreads();
    if (threadIdx.x == 0) {
        unsigned* bar = b.bar;
        __builtin_amdgcn_s_waitcnt(0);
        unsigned nloc = b.st[0], nx = b.st[1];
        if (nloc == 0u) { xcd_barrier_complete(bar, b.x, nloc, nx); b.st[0] = nloc; b.st[1] = nx; }
        const unsigned old = xb_add(&bar[XB_XSUB(b.x)], 1u);
        const unsigned gen = old / nloc;
        if (old + 1u == (gen + 1u) * nloc) {
            __builtin_amdgcn_fence(__ATOMIC_RELEASE, "agent");
            asm volatile("s_waitcnt vmcnt(0)" ::: "memory");
            const unsigned og = xb_add(&bar[XB_TOP], 1u);
            const unsigned tg = og / nx;
            if (og + 1u == (tg + 1u) * nx) xb_add(&bar[XB_TOPGEN], 1u);
            else XB_SPIN(xb_ld(&bar[XB_TOPGEN]) == tg, bar);
            __builtin_amdgcn_fence(__ATOMIC_ACQUIRE, "agent");
            xb_add(&bar[XB_XGEN(b.x)], 1u);
            asm volatile("s_waitcnt vmcnt(0)" ::: "memory");
        } else {
            XB_SPIN(xb_ld(&bar[XB_XGEN(b.x)]) == gen, bar);
            __builtin_amdgcn_fence(__ATOMIC_ACQUIRE, "agent");
            asm volatile("s_waitcnt vmcnt(0)" ::: "memory");
        }
    }
    __syncthreads();
}

#ifndef MK_PER_PHASE
#define MK_PER_PHASE 0
#endif
constexpr int N_PHASES = 29;
enum { OP_PREP = 0, OP_GEMM_SIDE, OP_ATTN, OP_GEMM_RES, OP_LN, OP_GEMM_UP, OP_SSD, OP_GNORM, OP_DIFF };

__global__ void __launch_bounds__(NTHREADS, 2) fwd_kernel(Ptrs Parg) {
    extern __shared__ __attribute__((aligned(16))) unsigned char lds_raw[];
    LAS unsigned char* lds = (LAS unsigned char*)lds_raw;
    const int ph_lo = Parg.ph_lo, ph_hi = Parg.ph_hi;
    {
        const int tid0 = threadIdx.x;
        for (int u = tid0; u < (LDS_BYTES - RING_BYTES) / 4; u += NTHREADS) ((LAS unsigned*)(lds + RING_BYTES))[u] = 0u;
        __syncthreads();
        if (ph_hi - ph_lo > 1) { if (tid0 == 0) (void)xb_add(&((unsigned*)(Parg.ws + WS_CTL) + 4096)[XB_XCNT(xb_xcc_id())], 1u); }
    }
    bool probe_rep = false;
    for (int ph = ph_lo; ph < ph_hi; ++ph) {
        int tid = threadIdx.x; asm volatile("" : "+v"(tid));
        KP P = (KP)__builtin_amdgcn_kernarg_segment_ptr(); asm volatile("" : "+s"(P));
        int bx = blockIdx.x; asm volatile("" : "+s"(bx));
        const int lane = tid & 63, wave = __builtin_amdgcn_readfirstlane(tid >> 6);
        const int G = gridDim.x;
        const int vcu = (G % 8 == 0) ? (bx % 8) * (G / 8) + bx / 8 : bx;
        const int gw = vcu * NWAVES + wave, NGW = G * NWAVES;
        unsigned char* ws = P->ws;
        bf16_t* XB = (bf16_t*)(ws + WS_XB);
        float* Z = (float*)(ws + WS_Z);
        float* XF = P->out;
        int op = OP_PREP, L = 0, t = 0;
        if (ph > 0) {
            const int q = ph - 1; int sub;
            if (q < 7) { L = 0; sub = q; } else if (q < 15) { L = 1; sub = q - 7; } else if (q < 21) { L = 2; sub = q - 15; } else { L = 3; sub = q - 21; }
            const int kind = L == 1 ? 1 : (L == 2 ? 2 : 0);
            const int npre = kind == 0 ? 2 : (kind == 1 ? 3 : 1);
            if (sub < npre) { op = kind == 0 ? (sub == 0 ? OP_GEMM_SIDE : OP_ATTN) : (kind == 1 ? (sub == 0 ? OP_GEMM_SIDE : (sub == 1 ? OP_SSD : OP_GNORM)) : OP_DIFF); }
            else { t = sub - npre; op = (t == 0 || t == 3) ? OP_GEMM_RES : ((t == 1 || t == 4) ? OP_LN : OP_GEMM_UP); }
        }
        const int kind = L == 1 ? 1 : (L == 2 ? 2 : 0);
        const int j = L / 3;
#ifndef ONLY_OP
#define ONLY_OP -1
#endif
#define EN(o) (ONLY_OP < 0 || ONLY_OP == (o))
#ifndef PROBE_MASK
#define PROBE_MASK 0
#endif
        if (EN(OP_PREP) && op == OP_PREP) {
            phase_prep(P, lds, gw, NGW, wave, lane);
        } else if (EN(OP_GEMM_SIDE) && op == OP_GEMM_SIDE) {
            pg8::Gemm g; pg8::EpiBf16Side E;
            g.A = XB; g.M = M; g.K = D; g.lda = D; g.ldb = D; g.a_pn_bytes = 0;
            E.out = P->out; E.j = j;
            if (kind == 0) { g.Bt = (const bf16_t*)(ws + WS_WQKV) + (size_t)j * QKV_N * D; g.N = QKV_N; E.O = (bf16_t*)(ws + WS_QKV); E.bias = P->in[9] + j * QKV_N; E.mode = 0; }
            else { g.Bt = (const bf16_t*)(ws + WS_WIN); g.N = SSM_INP; E.O = (bf16_t*)(ws + WS_ZX); E.bias = nullptr; E.mode = 1; }
            pg8::StaticOrder S; S.init(M, g.N, G, bx);
            pg8::gemm_phase<pg8::EpiBf16Side, pg8::StaticOrder, true, true>(lds, g, S, E, tid);
        } else if (EN(OP_ATTN) && op == OP_ATTN) {
            phase_attn((const bf16_t*)(ws + WS_QKV), (bf16_t*)(ws + WS_O), P->in[2] + (size_t)j * SB * WIN * 256, P->in[3] + (size_t)j * SB * WIN * 256, P->in[7], P->in[12] + j * NHQ,
                       P->out + O_KS + (size_t)j * SB * WIN * 256, P->out + O_VS + (size_t)j * SB * WIN * 256, lds, tid, wave, lane);
        } else if (EN(OP_GEMM_RES) && op == OP_GEMM_RES) {
            pg8::Gemm g; pg8::EpiRes E;
            g.M = M; g.N = D; g.a_pn_bytes = 0;
            E.Z = Z; E.bias = nullptr; E.scale = nullptr;
            if (L == 0 && t == 0) { E.baseP = P->in[0]; E.baseS = P->in[1]; } else { E.baseP = XF; E.baseS = XF + (size_t)MP * D; }
            if (t == 3) { g.A = (const bf16_t*)(ws + WS_H); g.lda = FF; g.Bt = (const bf16_t*)(ws + WS_WD) + (size_t)L * D * FF; g.ldb = FF; g.K = FF; }
            else if (kind == 0) { g.A = (const bf16_t*)(ws + WS_O); g.lda = D; g.Bt = (const bf16_t*)(ws + WS_WO) + (size_t)j * D * D; g.ldb = D; g.K = D; E.bias = P->in[11] + j * D; }
            else if (kind == 1) { g.A = (const bf16_t*)(ws + WS_Y); g.lda = DI; g.Bt = (const bf16_t*)(ws + WS_WOUT); g.ldb = DI; g.K = DI; }
            else { g.A = (const bf16_t*)(ws + WS_DIFF); g.lda = D; g.Bt = (const bf16_t*)(ws + WS_WPOOL); g.ldb = 256; g.K = 256; g.a_pn_bytes = 512; E.scale = P->in[22]; }
            pg8::StaticOrder S; S.init(M, D, G, bx);
            pg8::gemm_phase<pg8::EpiRes, pg8::StaticOrder, true, true>(lds, g, S, E, tid);
        } else if (EN(OP_LN) && op == OP_LN) {
            const int which = (t == 1) ? 0 : 1;
            phase_ln(Z, P->in[26] + (size_t)(L * 2 + which) * D, P->in[27] + (size_t)(L * 2 + which) * D, XF, XB, gw, NGW, lane);
        } else if (EN(OP_GEMM_UP) && op == OP_GEMM_UP) {
            pg8::Gemm g; g.A = XB; g.Bt = (const bf16_t*)(ws + WS_WGU) + (size_t)L * GU_N * D; g.M = M; g.N = GU_N; g.K = D; g.lda = D; g.ldb = D; g.a_pn_bytes = 0;
            pg8::EpiSwiGLU E; E.O = (bf16_t*)(ws + WS_H); E.ldc = FF;
            pg8::StaticOrder S; S.init(M, GU_N, G, bx);
            pg8::gemm_phase<pg8::EpiSwiGLU, pg8::StaticOrder, true, true>(lds, g, S, E, tid);
        } else if (EN(OP_SSD) && op == OP_SSD) {
            phase_ssd(P, lds, tid, wave, lane);
        } else if (EN(OP_GNORM) && op == OP_GNORM) {
            phase_gnorm(P, gw, NGW, lane);
        } else if (EN(OP_DIFF) && op == OP_DIFF) {
            phase_pooldiff(P, gw, NGW, lane);
        }
        if (PROBE_MASK) { if (((PROBE_MASK >> op) & 1) && !probe_rep) { probe_rep = true; --ph; } else probe_rep = false; }
        if (ph + 1 < ph_hi) { XcdBarrier bar; bar.bar = (unsigned*)(P->ws + WS_CTL) + 4096; bar.x = xb_xcc_id(); bar.st = (volatile LAS unsigned*)(lds + MISC_OFF) + 8; xcd_barrier(bar); }
    }
}

extern "C" void kernel_launch(void* const* d_in, const int* in_sizes, int n_in, void* d_out, int out_size, void* d_ws, size_t ws_size, hipStream_t stream) {
    static int grid = 0;
    if (grid == 0) {
        if (n_in != 28 || out_size != (int)O_END || ws_size < WS_END) { fprintf(stderr, "kernel_launch: unexpected shapes (n_in %d, out %d, ws %zu)\n", n_in, out_size, ws_size); grid = -1; return; }
        int dev = 0, cus = 0;
        if (hipGetDevice(&dev) != hipSuccess || hipDeviceGetAttribute(&cus, hipDeviceAttributeMultiprocessorCount, dev) != hipSuccess) { grid = -1; return; }
        if (hipFuncSetAttribute((const void*)fwd_kernel, hipFuncAttributeMaxDynamicSharedMemorySize, LDS_BYTES) != hipSuccess) { fprintf(stderr, "kernel_launch: hipFuncSetAttribute failed\n"); grid = -1; return; }
        (void)hipGetLastError();
        grid = cus;
    }
    if (grid < 0) return;
    (void)hipMemsetAsync((char*)d_ws + WS_CTL, 0, CTL_ZERO_BYTES, stream);
    Ptrs a{};
    for (int i = 0; i < 28; ++i) a.in[i] = (const float*)d_in[i];
    a.out = (float*)d_out; a.ws = (unsigned char*)d_ws;
#if MK_PER_PHASE
    for (int ph = 0; ph < N_PHASES; ++ph) { a.ph_lo = ph; a.ph_hi = ph + 1; hipLaunchKernelGGL(fwd_kernel, dim3(grid), dim3(NTHREADS), LDS_BYTES, stream, a); }
#else
    a.ph_lo = 0; a.ph_hi = N_PHASES;
    hipLaunchKernelGGL(fwd_kernel, dim3(grid), dim3(NTHREADS), LDS_BYTES, stream, a);
#endif
}
```

```cpp
#include <hip/hip_runtime.h>
#include <cstdio>
#include <cstdint>

#define LAS __attribute__((address_space(3)))
#define GAS __attribute__((address_space(1)))
typedef unsigned short bf16_t;
typedef short bf16x8 __attribute__((ext_vector_type(8)));
typedef float f32x4 __attribute__((ext_vector_type(4)));
typedef float f32x2 __attribute__((ext_vector_type(2)));
typedef unsigned u32x4 __attribute__((ext_vector_type(4)));
typedef unsigned u32x2 __attribute__((ext_vector_type(2)));

constexpr int D = 1024;
constexpr int PB = 8, PL = 2048, MP = PB * PL;
constexpr int SB = 128, SL = 8, MS = SB * SL;
constexpr int M = MP + MS;
constexpr int NKV = 4, HD = 64, NHQ = 16, WIN = 128;
constexpr int QKV_N = 1536, KCOL = 1024, VCOL = 1280;
constexpr int FF = 2816, GU_N = 2 * FF;
constexpr int DI = 2048, CONV_D = 3072, SSM_IN = 5152, SSM_INP = 5376, SH = 32, SP = 64, SN = 128;
constexpr int XBC_COL = 2048, DT_COL = 5120;
constexpr int DEPTH = 4;
constexpr float LN_EPS = 1e-5f, RMS_EPS = 1e-5f;
constexpr float ALPHA = 1.6817928305074290f;

constexpr size_t O_Y = 0;
constexpr size_t O_KP = (size_t)M * D;
constexpr size_t O_VP = O_KP + (size_t)2 * PB * WIN * 256;
constexpr size_t O_CP = O_VP + (size_t)2 * PB * WIN * 256;
constexpr size_t O_SP = O_CP + (size_t)PB * 3 * CONV_D;
constexpr size_t O_PP = O_SP + (size_t)PB * SH * SP * SN;
constexpr size_t O_KS = O_PP + (size_t)PB * 15 * D;
constexpr size_t O_VS = O_KS + (size_t)2 * SB * WIN * 256;
constexpr size_t O_CS = O_VS + (size_t)2 * SB * WIN * 256;
constexpr size_t O_SS = O_CS + (size_t)SB * 3 * CONV_D;
constexpr size_t O_PS = O_SS + (size_t)SB * SH * SP * SN;
constexpr size_t O_END = O_PS + (size_t)SB * 15 * D;
static_assert(O_END == 74645504, "output size");

constexpr size_t MiB = 1u << 20;
constexpr size_t WS_CTL = 0, CTL_ZERO_BYTES = 1 * MiB;
constexpr size_t WS_WQKV = 1 * MiB;
constexpr size_t WS_WO = WS_WQKV + 6 * MiB;
constexpr size_t WS_WIN = WS_WO + 4 * MiB;
constexpr size_t WS_WOUT = WS_WIN + 11 * MiB;
constexpr size_t WS_WPOOL = WS_WOUT + 4 * MiB;
constexpr size_t WS_WGU = WS_WPOOL + 1 * MiB;
constexpr size_t WS_WD = WS_WGU + 44 * MiB;
constexpr size_t WS_XB = WS_WD + 22 * MiB;
constexpr size_t WS_Z = WS_XB + 34 * MiB;
constexpr size_t WS_BIG = WS_Z + 68 * MiB;
constexpr size_t WS_QKV = WS_BIG;
constexpr size_t WS_O = WS_BIG + 52 * MiB;
constexpr size_t WS_H = WS_BIG;
constexpr size_t WS_ZX = WS_BIG;
constexpr size_t WS_Y = WS_BIG + 180 * MiB;
constexpr size_t WS_DIFF = WS_BIG;
constexpr size_t WS_END = WS_BIG + 250 * MiB;
static_assert(WS_END <= 512 * MiB, "d_ws map");

__device__ __forceinline__ unsigned f2bf(float f) { unsigned u = __builtin_bit_cast(unsigned, f); return (u + 0x7fffu + ((u >> 16) & 1u)) >> 16; }
typedef __bf16 bf16x2_hw __attribute__((ext_vector_type(2)));
__device__ __forceinline__ unsigned pk2(float lo, float hi) { f32x2 v = {lo, hi}; return __builtin_bit_cast(unsigned, __builtin_convertvector(v, bf16x2_hw)); }
__device__ __forceinline__ float bflo(unsigned w) { return __builtin_bit_cast(float, w << 16); }
__device__ __forceinline__ float bfhi(unsigned w) { return __builtin_bit_cast(float, w & 0xffff0000u); }
__device__ __forceinline__ float bf1(bf16_t h) { return __builtin_bit_cast(float, (unsigned)h << 16); }
__device__ __forceinline__ float silu_f(float x) { return x / (1.0f + __expf(-x)); }
__device__ __forceinline__ float wave_sum(float v) {
#pragma unroll
    for (int o = 1; o < 64; o <<= 1) v += __shfl_xor(v, o);
    return v;
}
__device__ __forceinline__ float wave_max(float v) {
#pragma unroll
    for (int o = 1; o < 64; o <<= 1) v = fmaxf(v, __shfl_xor(v, o));
    return v;
}

namespace pg8 {
#define PG8_LAS __attribute__((address_space(3)))
constexpr int BM = 256, BK = 64, HALF = 128, HTB = HALF * BK * 2  , STAGE_BYTES = 8 * HTB, NXCD = 8, WGM = 8;

__host__ __device__ __forceinline__ int lds_byte(int r, int c) { const int st = (r >> 4) * 2 + (c >> 5), rr = r & 15, cc = c & 31, ob = rr * 64 + cc * 2; return st * 1024 + (ob ^ (((ob >> 9) & 1) << 5)); }
__host__ __device__ __forceinline__ void stage_rc(int b, int& R, int& C) { const int st = b / 1024, sb = b % 1024, swz = sb ^ (((sb >> 9) & 1) << 5); R = (st >> 1) * 16 + swz / 64; C = (st & 1) * 32 + (swz % 64) / 2; }
__host__ __device__ __forceinline__ int perm32(int rho) { const int n = rho >> 4, i = rho & 15; return 8 * (i >> 2) + 4 * n + (i & 3); }

struct Unit { int pm, pn; };
struct Gemm { const bf16_t* A; const bf16_t* Bt; int M, N, K, lda, ldb; size_t a_pn_bytes; };

struct StaticOrder {
    int nM, nN, nwg, G, c;
    __host__ __device__ void init(int M_, int N_, int G_, int c_) { nM = M_ / BM; nN = N_ / BM; nwg = nM * nN; G = G_; c = c_; }
    __host__ __device__ bool next(int i, Unit& u) const {
        const long L = (long)i * G + c; if (L >= nwg) return false;
        int wgid = (int)L; { const int q = nwg / NXCD, r = nwg % NXCD, xcd = wgid % NXCD, off = wgid / NXCD; wgid = (xcd < r ? xcd * (q + 1) : r * (q + 1) + (xcd - r) * q) + off; }
        const int nig = WGM * nN, gid = wgid / nig, fm = gid * WGM, gsz = (nM - fm) < WGM ? (nM - fm) : WGM;
        u.pm = fm + ((wgid % nig) % gsz); u.pn = (wgid % nig) / gsz; return true;
    }
    __device__ __forceinline__ void a_ready(const Unit&) const {}
    __device__ __forceinline__ void done(const Unit&) const {}
};


struct EpiBf16Side {
    static constexpr bool PERM = true, AFTER_DRAIN = false;
    bf16_t* O; const float* bias; float* out; int mode, j;
    __device__ __forceinline__ void operator()(const f32x4 (&acc)[2][2][4][2], const Unit& u, int wr, int wc, int fr, int fq) const {
        const int ldc = mode == 0 ? QKV_N : SSM_INP;
        const int side_lo = mode == 0 ? KCOL : XBC_COL, side_hi = mode == 0 ? QKV_N : DT_COL, split = mode == 0 ? VCOL : (1 << 30), side_w = mode == 0 ? 256 : CONV_D;
        const int tailP = mode == 0 ? WIN : 3, rowsP = tailP, tailS = mode == 0 ? SL : 3, rowsS = mode == 0 ? WIN : 3;
        const int colt = u.pn * BM;
        const int c8 = colt + wc * 32 + 8 * fq;
        f32x4 bv[2][2];
#pragma unroll
        for (int bj = 0; bj < 2; ++bj)
#pragma unroll
            for (int n = 0; n < 2; ++n) bv[bj][n] = bias ? *(const f32x4*)(bias + c8 + bj * HALF + 4 * n) : (f32x4){0.f, 0.f, 0.f, 0.f};
        const bool has_side = (colt >= side_lo) && (colt < side_hi);
        const bool second = colt >= split;
        const int corg = second ? split : side_lo;
        float* sideP = out + (mode == 0 ? (second ? O_VP : O_KP) + (size_t)j * PB * WIN * 256 : O_CP);
        float* sideS = out + (mode == 0 ? (second ? O_VS : O_KS) + (size_t)j * SB * WIN * 256 : O_CS);
#pragma unroll
        for (int ai = 0; ai < 2; ++ai)
#pragma unroll
            for (int m = 0; m < 4; ++m) {
                const int row = u.pm * BM + ai * HALF + wr * 64 + m * 16 + fr;
                bf16_t* rowp = O + (size_t)row * ldc + c8;
                float* sp = nullptr;
                if (has_side) {
                    if (row < MP) { const int pos = row & (PL - 1), b = row >> 11; if (pos >= PL - tailP) sp = sideP + ((size_t)b * rowsP + (pos - (PL - tailP))) * side_w; }
                    else { const int rs = row - MP, b = rs >> 3, i = rs & 7; if (i >= SL - tailS) sp = sideS + ((size_t)b * rowsS + (rowsS - tailS) + (i - (SL - tailS))) * side_w; }
                }
#pragma unroll
                for (int bj = 0; bj < 2; ++bj) {
                    const f32x4 v0 = acc[ai][bj][m][0] + bv[bj][0], v1 = acc[ai][bj][m][1] + bv[bj][1];
                    u32x4 w; w.x = pk2(v0[0], v0[1]); w.y = pk2(v0[2], v0[3]); w.z = pk2(v1[0], v1[1]); w.w = pk2(v1[2], v1[3]);
                    *(u32x4*)(rowp + bj * HALF) = w;
                    if (sp) { float* q = sp + (c8 + bj * HALF - corg); *(f32x4*)q = v0; *(f32x4*)(q + 4) = v1; }
                }
                asm volatile("" ::: "memory");
            }
    }
};

struct EpiSwiGLU {
    static constexpr bool PERM = true, AFTER_DRAIN = false;
    bf16_t* O; int ldc;
    __device__ __forceinline__ void operator()(const f32x4 (&acc)[2][2][4][2], const Unit& u, int wr, int wc, int fr, int fq) const {
        const int c8 = u.pn * HALF + wc * 32 + 8 * fq;
#pragma unroll
        for (int ai = 0; ai < 2; ++ai)
#pragma unroll
            for (int m = 0; m < 4; ++m) {
                const int row = u.pm * BM + ai * HALF + wr * 64 + m * 16 + fr;
                const f32x4 g0 = acc[ai][0][m][0], g1 = acc[ai][0][m][1], u0 = acc[ai][1][m][0], u1 = acc[ai][1][m][1];
                u32x4 w;
                w.x = pk2(silu_f(g0[0]) * u0[0], silu_f(g0[1]) * u0[1]); w.y = pk2(silu_f(g0[2]) * u0[2], silu_f(g0[3]) * u0[3]);
                w.z = pk2(silu_f(g1[0]) * u1[0], silu_f(g1[1]) * u1[1]); w.w = pk2(silu_f(g1[2]) * u1[2], silu_f(g1[3]) * u1[3]);
                *(u32x4*)(O + (size_t)row * ldc + c8) = w;
                asm volatile("" ::: "memory");
            }
    }
};

struct EpiRes {
    static constexpr bool PERM = false, AFTER_DRAIN = false;
    float* Z; const float* baseP; const float* baseS; const float* bias; const float* scale;
    __device__ __forceinline__ void operator()(const f32x4 (&acc)[2][2][4][2], const Unit& u, int wr, int wc, int fr, int fq) const {
        const int col0 = u.pn * BM + wc * 32 + 4 * fq;
        f32x4 bv[2][2], sv[2][2];
#pragma unroll
        for (int bj = 0; bj < 2; ++bj)
#pragma unroll
            for (int n = 0; n < 2; ++n) {
                bv[bj][n] = bias ? *(const f32x4*)(bias + col0 + bj * HALF + n * 16) : (f32x4){0.f, 0.f, 0.f, 0.f};
                sv[bj][n] = scale ? *(const f32x4*)(scale + col0 + bj * HALF + n * 16) : (f32x4){1.f, 1.f, 1.f, 1.f};
            }
#pragma unroll
        for (int ai = 0; ai < 2; ++ai)
#pragma unroll
            for (int m = 0; m < 4; ++m) {
                const int row = u.pm * BM + ai * HALF + wr * 64 + m * 16 + fr;
                const float* bp = (row < MP ? baseP + (size_t)row * D : baseS + (size_t)(row - MP) * D) + col0;
                float* zp = Z + (size_t)row * D + col0;
#pragma unroll
                for (int bj = 0; bj < 2; ++bj)
#pragma unroll
                    for (int n = 0; n < 2; ++n) {
                        const f32x4 b = *(const f32x4*)(bp + bj * HALF + n * 16);
                        *(f32x4*)(zp + bj * HALF + n * 16) = b * ALPHA + (acc[ai][bj][m][n] + bv[bj][n]) * sv[bj][n];
                    }
                asm volatile("" ::: "memory");
            }
    }
};

template <class Epi, class Sched, bool ALIGN_EPI = false, bool SP2 = false>
__device__ __forceinline__ void gemm_phase(PG8_LAS unsigned char* lds, const Gemm g, const Sched& S, const Epi& E, const int tid) {
    const int wid = __builtin_amdgcn_readfirstlane(tid >> 6), lane = tid & 63, wr = wid >> 2, wc = wid & 3, fr = lane & 15, fq = lane >> 4;
    const int K = g.K, nt = K / BK, lda = g.lda, ldb = g.ldb;
    unsigned voffA[2], voffB[2];
#pragma unroll
    for (int i = 0; i < 2; ++i) { int R, C; stage_rc(tid * 16 + i * 8192, R, C); const int Rb = Epi::PERM ? ((R & ~31) + perm32(R & 31)) : R;
        voffA[i] = (unsigned)(R * lda + C) * 2u; voffB[i] = (unsigned)(Rb * ldb + C) * 2u; }
    const size_t kstep = (size_t)(BK * 2);
    const size_t hstepA = (size_t)HALF * lda * 2, hstepB = (size_t)HALF * ldb * 2;
    const size_t tstepA = 2 * hstepA, tstepB = 2 * hstepB;
    const size_t apn = g.a_pn_bytes;
    const unsigned ldsw = (unsigned)wid * 1024u;
    const int aoff = lds_byte(wr * 64 + fr, fq * 8), boff = lds_byte(wc * 32 + fr, fq * 8);
#define PG8_SA(b, h) (((b) * 2 + (h)) * HTB)
#define PG8_SB(b, h) ((4 + (b) * 2 + (h)) * HTB)
#define PG8_STAGE(bufoff, gbase, voff) do { _Pragma("unroll") for (int _i = 0; _i < 2; ++_i) \
        __builtin_amdgcn_global_load_lds((const unsigned*)((const char*)(gbase) + (voff)[_i]), (PG8_LAS unsigned*)(lds + (bufoff) + ldsw + _i * 8192), 16, 0, 0); } while (0)
#define PG8_LDA(dst, b, h) do { _Pragma("unroll") for (int m = 0; m < 4; ++m) _Pragma("unroll") for (int k = 0; k < 2; ++k) dst[m][k] = *(const PG8_LAS bf16x8*)(lds + PG8_SA(b, h) + aoff + m * 2048 + k * 1024); } while (0)
#define PG8_LDB(dst, b, h) do { _Pragma("unroll") for (int n = 0; n < 2; ++n) _Pragma("unroll") for (int k = 0; k < 2; ++k) dst[n][k] = *(const PG8_LAS bf16x8*)(lds + PG8_SB(b, h) + boff + n * 2048 + k * 1024); } while (0)
#define PG8_MMA(ai, bj, At, Bt) do { __builtin_amdgcn_s_setprio(1); _Pragma("unroll") for (int m = 0; m < 4; ++m) _Pragma("unroll") for (int n = 0; n < 2; ++n) _Pragma("unroll") for (int k = 0; k < 2; ++k) \
        acc[ai][bj][m][n] = __builtin_amdgcn_mfma_f32_16x16x32_bf16(Bt[n][k], At[m][k], acc[ai][bj][m][n], 0, 0, 0); __builtin_amdgcn_s_setprio(0); } while (0)
#define PG8_WAIT_V(n) asm volatile("s_waitcnt vmcnt(" #n ")" ::: "memory")
#define PG8_WAIT_L(n) asm volatile("s_waitcnt lgkmcnt(" #n ")" ::: "memory")
#define PG8_BAR __builtin_amdgcn_s_barrier()
#define PG8_SCHED __builtin_amdgcn_sched_barrier(0)
    Unit cur, nxt; int ui = 0;
    if (!S.next(0, cur)) return;
    f32x4 acc[2][2][4][2];
#pragma unroll
    for (int a = 0; a < 2; ++a)
#pragma unroll
        for (int b = 0; b < 2; ++b)
#pragma unroll
            for (int m = 0; m < 4; ++m)
#pragma unroll
                for (int n = 0; n < 2; ++n) acc[a][b][m][n] = (f32x4){0.f, 0.f, 0.f, 0.f};
    bf16x8 At[4][2], B0[2][2], B1[2][2];
    const char* cA = (const char*)g.A + (size_t)cur.pm * tstepA + (size_t)cur.pn * apn; const char* cB = (const char*)g.Bt + (size_t)cur.pn * tstepB;
    S.a_ready(cur);
    if constexpr (SP2) {
        PG8_STAGE(PG8_SB(0, 0), cB, voffB); PG8_STAGE(PG8_SB(0, 1), cB + hstepB, voffB); PG8_STAGE(PG8_SA(0, 0), cA, voffA); PG8_STAGE(PG8_SA(0, 1), cA + hstepA, voffA);
        if (wr == 1) PG8_BAR;
        PG8_WAIT_V(2); PG8_BAR;
        PG8_STAGE(PG8_SB(1, 0), cB + kstep, voffB); PG8_STAGE(PG8_SA(1, 0), cA + kstep, voffA); PG8_STAGE(PG8_SB(1, 1), cB + hstepB + kstep, voffB);
        PG8_WAIT_V(6); PG8_BAR;
    } else {
        PG8_STAGE(PG8_SB(0, 0), cB, voffB); PG8_STAGE(PG8_SA(0, 0), cA, voffA); PG8_STAGE(PG8_SB(0, 1), cB + hstepB, voffB); PG8_STAGE(PG8_SA(0, 1), cA + hstepA, voffA);
        if (wr == 1) PG8_BAR;
        PG8_WAIT_V(4); PG8_BAR;
        PG8_STAGE(PG8_SB(1, 0), cB + kstep, voffB); PG8_STAGE(PG8_SA(1, 0), cA + kstep, voffA); PG8_STAGE(PG8_SB(1, 1), cB + hstepB + kstep, voffB);
        PG8_WAIT_V(6); PG8_BAR;
    }
    for (;;) {
        const bool has_next = S.next(ui + 1, nxt);
        const char* nA = has_next ? (const char*)g.A + (size_t)nxt.pm * tstepA + (size_t)nxt.pn * apn : cA; const char* nB = has_next ? (const char*)g.Bt + (size_t)nxt.pn * tstepB : cB;
        for (int t = 0; t < nt; t += 2) {
            const bool last = (t == nt - 2);
            const char* a1 = cA + (size_t)(t + 1) * kstep;
            const char* a2 = last ? nA : cA + (size_t)(t + 2) * kstep; const char* b2 = last ? nB : cB + (size_t)(t + 2) * kstep;
            const char* a3 = a2 + kstep; const char* b3 = b2 + kstep;
            if (last && has_next) S.a_ready(nxt);
            if constexpr (SP2) {
            PG8_LDB(B0, 0, 0); PG8_LDB(B1, 0, 1); PG8_SCHED; PG8_LDA(At, 0, 0); PG8_STAGE(PG8_SA(1, 1), a1 + hstepA, voffA);
            PG8_WAIT_V(8); PG8_WAIT_L(0); PG8_BAR; PG8_MMA(0, 0, At, B0); PG8_MMA(0, 1, At, B1); PG8_BAR; PG8_SCHED;
            PG8_LDA(At, 0, 1); PG8_STAGE(PG8_SB(0, 0), b2, voffB); PG8_STAGE(PG8_SB(0, 1), b2 + hstepB, voffB); PG8_STAGE(PG8_SA(0, 0), a2, voffA);
            PG8_WAIT_V(8); PG8_WAIT_L(0); PG8_BAR; PG8_MMA(1, 0, At, B0); PG8_MMA(1, 1, At, B1); PG8_BAR; PG8_SCHED;
            PG8_LDB(B0, 1, 0); PG8_LDB(B1, 1, 1); PG8_SCHED; PG8_LDA(At, 1, 0); PG8_STAGE(PG8_SA(0, 1), a2 + hstepA, voffA);
            PG8_WAIT_V(8); PG8_WAIT_L(0); PG8_BAR; PG8_MMA(0, 0, At, B0); PG8_MMA(0, 1, At, B1); PG8_BAR; PG8_SCHED;
            PG8_LDA(At, 1, 1); PG8_STAGE(PG8_SB(1, 0), b3, voffB); PG8_STAGE(PG8_SB(1, 1), b3 + hstepB, voffB); PG8_STAGE(PG8_SA(1, 0), a3, voffA);
            PG8_WAIT_V(8); PG8_WAIT_L(0); PG8_BAR; PG8_MMA(1, 0, At, B0); PG8_MMA(1, 1, At, B1); PG8_BAR; PG8_SCHED;
            } else {
            PG8_LDB(B0, 0, 0); PG8_SCHED; PG8_LDA(At, 0, 0); PG8_STAGE(PG8_SA(1, 1), a1 + hstepA, voffA);
            PG8_WAIT_L(8); PG8_BAR; PG8_WAIT_L(0); PG8_MMA(0, 0, At, B0); PG8_BAR; PG8_SCHED;
            PG8_LDB(B1, 0, 1); PG8_STAGE(PG8_SB(0, 0), b2, voffB);
            PG8_BAR; PG8_WAIT_L(0); PG8_MMA(0, 1, At, B1); PG8_BAR;
            PG8_LDA(At, 0, 1); PG8_STAGE(PG8_SA(0, 0), a2, voffA);
            PG8_BAR; PG8_WAIT_L(0); PG8_MMA(1, 0, At, B0); PG8_BAR; PG8_SCHED;
            PG8_STAGE(PG8_SB(0, 1), b2 + hstepB, voffB);
            PG8_WAIT_V(6); PG8_BAR; PG8_MMA(1, 1, At, B1); PG8_BAR;
            PG8_LDB(B0, 1, 0); PG8_SCHED; PG8_LDA(At, 1, 0); PG8_STAGE(PG8_SA(0, 1), a2 + hstepA, voffA);
            PG8_WAIT_L(8); PG8_BAR; PG8_WAIT_L(0); PG8_MMA(0, 0, At, B0); PG8_BAR; PG8_SCHED;
            PG8_LDB(B1, 1, 1); PG8_STAGE(PG8_SB(1, 0), b3, voffB);
            PG8_BAR; PG8_WAIT_L(0); PG8_MMA(0, 1, At, B1); PG8_BAR;
            PG8_LDA(At, 1, 1); PG8_STAGE(PG8_SA(1, 0), a3, voffA);
            PG8_BAR; PG8_WAIT_L(0); PG8_MMA(1, 0, At, B0); PG8_BAR; PG8_SCHED;
            PG8_STAGE(PG8_SB(1, 1), b3 + hstepB, voffB);
            PG8_WAIT_V(6); PG8_BAR; PG8_MMA(1, 1, At, B1); PG8_BAR;
            }
        }
        if constexpr (ALIGN_EPI) { if (wr == 0) PG8_BAR; }
        if constexpr (!Epi::AFTER_DRAIN) { E(acc, cur, wr, wc, fr, fq); S.done(cur); }
        if (!has_next) break;
#pragma unroll
        for (int a = 0; a < 2; ++a)
#pragma unroll
            for (int b = 0; b < 2; ++b)
#pragma unroll
                for (int m = 0; m < 4; ++m)
#pragma unroll
                    for (int n = 0; n < 2; ++n) acc[a][b][m][n] = (f32x4){0.f, 0.f, 0.f, 0.f};
        cur = nxt; cA = nA; cB = nB; ++ui;
        if constexpr (ALIGN_EPI) { if (wr == 1) PG8_BAR; }
    }
    PG8_WAIT_V(0);
    if constexpr (!ALIGN_EPI) { if (wr == 0) PG8_BAR; }
    PG8_BAR;
    if constexpr (Epi::AFTER_DRAIN) { E.fused(acc, cur, wr, wc, fr, fq, lds, wid, lane); S.done(cur); }
#undef PG8_SA
#undef PG8_SB
#undef PG8_STAGE
#undef PG8_LDA
#undef PG8_LDB
#undef PG8_MMA
#undef PG8_WAIT_V
#undef PG8_WAIT_L
#undef PG8_BAR
#undef PG8_SCHED
}
}

constexpr int NWAVES = 8, NTHREADS = NWAVES * 64;
constexpr int RING_BYTES = 147456;
constexpr int MISC_OFF = RING_BYTES + 320;
constexpr int LDS_BYTES = 155648;

struct Ptrs {
    const float* in[28];
    float* out;
    unsigned char* ws;
    int ph_lo, ph_hi;
};
typedef const __attribute__((address_space(4))) Ptrs* KP;

__device__ __forceinline__ void p0_item(const float* W, int N, bf16_t* WT, int ldk, int k0, int n0, int dst_row0, LAS float* scr, int lane) {
#pragma unroll 8
    for (int i = 0; i < 32; ++i) { const int kk = 2 * i + (lane >> 5); scr[kk * 33 + (lane & 31)] = W[(size_t)(k0 + kk) * N + n0 + (lane & 31)]; }
    asm volatile("s_waitcnt lgkmcnt(0)" ::: "memory");
    const int c = lane & 7;
#pragma unroll
    for (int j = 0; j < 4; ++j) { const int n = (lane >> 3) + 8 * j; const LAS float* s = scr + (8 * c) * 33 + n;
        u32x4 o; o.x = pk2(s[0 * 33], s[1 * 33]); o.y = pk2(s[2 * 33], s[3 * 33]); o.z = pk2(s[4 * 33], s[5 * 33]); o.w = pk2(s[6 * 33], s[7 * 33]);
        *(u32x4*)(WT + (size_t)(dst_row0 + n) * ldk + k0 + 8 * c) = o; }
    asm volatile("s_waitcnt lgkmcnt(0)" ::: "memory");
}
__device__ __forceinline__ void p0_mat(const float* W, int K, int N, bf16_t* WT, int mode  , int r, LAS float* scr, int lane) {
    const int nblk = N / 32, kb = r / nblk, nb = r % nblk, k0 = 64 * kb, n0 = 32 * nb;
    int dr = n0;
    if (mode == 1) dr = 256 * (n0 >> 7) + (n0 & 127);
    if (mode == 2) dr = 256 * (n0 >> 7) + 128 + (n0 & 127);
    p0_item(W, N, WT, K, k0, n0, dr, scr, lane);
}
__device__ __forceinline__ void phase_prep(KP P, LAS unsigned char* lds, int gw, int NGW, int wave, int lane) {
    LAS float* scr = (LAS float*)(lds + wave * 16384);
    unsigned char* ws = P->ws;
    constexpr int I_QKV = 16 * 48, I_O = 16 * 32, I_IN = 16 * 161, I_OUT = 32 * 32, I_POOL = 4 * 8, I_G = 16 * 88, I_DN = 44 * 32;
    constexpr int N_ITEMS = 2 * I_QKV + 2 * I_O + I_IN + I_OUT + 4 * I_POOL + 4 * (2 * I_G + I_DN);
    for (int it = gw; it < N_ITEMS; it += NGW) {
        int r = it;
        if (r < 2 * I_QKV) { const int j = r / I_QKV; r -= j * I_QKV; p0_mat(P->in[8] + (size_t)j * D * QKV_N, D, QKV_N, (bf16_t*)(ws + WS_WQKV) + (size_t)j * QKV_N * D, 0, r, scr, lane); continue; } r -= 2 * I_QKV;
        if (r < 2 * I_O) { const int j = r / I_O; r -= j * I_O; p0_mat(P->in[10] + (size_t)j * D * D, D, D, (bf16_t*)(ws + WS_WO) + (size_t)j * D * D, 0, r, scr, lane); continue; } r -= 2 * I_O;
        if (r < I_IN) { p0_mat(P->in[13], D, SSM_IN, (bf16_t*)(ws + WS_WIN), 0, r, scr, lane); continue; } r -= I_IN;
        if (r < I_OUT) { p0_mat(P->in[20], DI, D, (bf16_t*)(ws + WS_WOUT), 0, r, scr, lane); continue; } r -= I_OUT;
        if (r < 4 * I_POOL) { const int g = r / I_POOL; r -= g * I_POOL; p0_mat(P->in[21] + (size_t)g * 256 * 256, 256, 256, (bf16_t*)(ws + WS_WPOOL) + (size_t)g * 256 * 256, 0, r, scr, lane); continue; } r -= 4 * I_POOL;
        { const int per = 2 * I_G + I_DN, i = r / per; r -= i * per;
          if (r < I_G) { p0_mat(P->in[23] + (size_t)i * D * FF, D, FF, (bf16_t*)(ws + WS_WGU) + (size_t)i * GU_N * D, 1, r, scr, lane); continue; } r -= I_G;
          if (r < I_G) { p0_mat(P->in[24] + (size_t)i * D * FF, D, FF, (bf16_t*)(ws + WS_WGU) + (size_t)i * GU_N * D, 2, r, scr, lane); continue; } r -= I_G;
          p0_mat(P->in[25] + (size_t)i * FF * D, FF, D, (bf16_t*)(ws + WS_WD) + (size_t)i * D * FF, 0, r, scr, lane); }
    }
    { const int gt = gw * 64 + lane, NT = NGW * 64; u32x4* z = (u32x4*)((bf16_t*)(ws + WS_WIN) + (size_t)SSM_IN * D);
      for (int i = gt; i < (SSM_INP - SSM_IN) * D / 8; i += NT) z[i] = (u32x4){0u, 0u, 0u, 0u}; }
    { const int gt = gw * 64 + lane, NT = NGW * 64; bf16_t* XB = (bf16_t*)(ws + WS_XB);
      for (int i = gt; i < M * D / 8; i += NT) { const int row = i >> 7, c = (i & 127) * 8;
          const float* src = (row < MP ? P->in[0] + (size_t)row * D : P->in[1] + (size_t)(row - MP) * D) + c;
          const f32x4 a = *(const f32x4*)src, b = *(const f32x4*)(src + 4);
          u32x4 w; w.x = pk2(a[0], a[1]); w.y = pk2(a[2], a[3]); w.z = pk2(b[0], b[1]); w.w = pk2(b[2], b[3]);
          *(u32x4*)(XB + (size_t)row * D + c) = w; } }
}

__device__ __forceinline__ void phase_ln(const float* Z, const float* g, const float* b, float* XF, bf16_t* XB, int gw, int NGW, int lane) {
    f32x4 gv[4], bv[4];
#pragma unroll
    for (int j = 0; j < 4; ++j) { gv[j] = *(const f32x4*)(g + 256 * j + 4 * lane); bv[j] = *(const f32x4*)(b + 256 * j + 4 * lane); }
    for (int row = gw; row < M; row += NGW) {
        const float* zr = Z + (size_t)row * D + 4 * lane;
        f32x4 v[4]; float s = 0.f;
#pragma unroll
        for (int j = 0; j < 4; ++j) { v[j] = *(const f32x4*)(zr + 256 * j); s += (v[j][0] + v[j][1]) + (v[j][2] + v[j][3]); }
        const float mean = wave_sum(s) * (1.f / D); float s2 = 0.f;
#pragma unroll
        for (int j = 0; j < 4; ++j) { v[j] = v[j] - mean; s2 += (v[j][0] * v[j][0] + v[j][1] * v[j][1]) + (v[j][2] * v[j][2] + v[j][3] * v[j][3]); }
        const float rstd = 1.0f / sqrtf(wave_sum(s2) * (1.f / D) + LN_EPS);
        float* xo = XF + (size_t)row * D + 4 * lane; bf16_t* bo = XB + (size_t)row * D + 4 * lane;
#pragma unroll
        for (int j = 0; j < 4; ++j) { const f32x4 o = v[j] * rstd * gv[j] + bv[j]; *(f32x4*)(xo + 256 * j) = o;
            u32x2 w; w.x = pk2(o[0], o[1]); w.y = pk2(o[2], o[3]); *(u32x2*)(bo + 256 * j) = w; }
    }
}

__device__ __forceinline__ int t5_bucket(int n) {
    if (n < 16) return n;
    const int l = 16 + (int)(__log2f((float)n * (1.0f / 16.0f)) * (16.0f / 3.0f));
    return l < 31 ? l : 31;
}
typedef float f32x16 __attribute__((ext_vector_type(16)));
constexpr int AT_KSTR = 72, AT_VSTR = 260;
constexpr int AT_TBL = 0, AT_K = 16 * 192 * 4, AT_V = AT_K + 256 * AT_KSTR * 2, AT_END = AT_V + 64 * AT_VSTR * 2;
static_assert(AT_END <= RING_BYTES, "attention LDS");

__device__ __forceinline__ void attn_sub(const LAS bf16_t* Ks, const LAS bf16_t* Vts, const LAS float* tblh, const bf16x8 (&qf)[4], int kb0, int dist0, int kmin, float sink,
                                         bf16_t* orow  , int lane) {
    const int l31 = lane & 31, h = lane >> 5;
    f32x16 s[5];
#pragma unroll
    for (int kt = 0; kt < 5; ++kt) {
        f32x16 acc = {0.f, 0.f, 0.f, 0.f, 0.f, 0.f, 0.f, 0.f, 0.f, 0.f, 0.f, 0.f, 0.f, 0.f, 0.f, 0.f};
        const LAS bf16_t* kp = Ks + (kb0 + kt * 32 + l31) * AT_KSTR + 8 * h;
#pragma unroll
        for (int ds = 0; ds < 4; ++ds) { const bf16x8 a = *(const LAS bf16x8*)(kp + 16 * ds); acc = __builtin_amdgcn_mfma_f32_32x32x16_bf16(a, qf[ds], acc, 0, 0, 0); }
        s[kt] = acc;
    }
    float mx = sink;
#pragma unroll
    for (int kt = 0; kt < 5; ++kt)
#pragma unroll
        for (int r = 0; r < 16; ++r) {
            const int kb = kb0 + kt * 32 + (r & 3) + 8 * (r >> 2) + 4 * h;
            float v = s[kt][r] * 0.125f + tblh[dist0 - kb + 31];
            if (kb < kmin) v = -INFINITY;
            s[kt][r] = v; mx = fmaxf(mx, v);
        }
    mx = fmaxf(mx, __shfl_xor(mx, 32));
    float sum = 0.f;
#pragma unroll
    for (int kt = 0; kt < 5; ++kt)
#pragma unroll
        for (int r = 0; r < 16; ++r) { const float p = __expf(s[kt][r] - mx); s[kt][r] = p; sum += p; }
    sum += __shfl_xor(sum, 32);
    sum += __expf(sink - mx);
    const float inv = 1.0f / sum;
    f32x16 o0 = {0.f, 0.f, 0.f, 0.f, 0.f, 0.f, 0.f, 0.f, 0.f, 0.f, 0.f, 0.f, 0.f, 0.f, 0.f, 0.f}, o1 = o0;
#pragma unroll
    for (int kt = 0; kt < 5; ++kt)
#pragma unroll
        for (int s2 = 0; s2 < 2; ++s2) {
            u32x4 pw; pw.x = pk2(s[kt][8 * s2 + 0], s[kt][8 * s2 + 1]); pw.y = pk2(s[kt][8 * s2 + 2], s[kt][8 * s2 + 3]); pw.z = pk2(s[kt][8 * s2 + 4], s[kt][8 * s2 + 5]); pw.w = pk2(s[kt][8 * s2 + 6], s[kt][8 * s2 + 7]);
            const bf16x8 pb = __builtin_bit_cast(bf16x8, pw);
            const LAS bf16_t* vp = Vts + l31 * AT_VSTR + kb0 + kt * 32 + 16 * s2 + 4 * h;
            { const u32x2 lo = *(const LAS u32x2*)vp, hi = *(const LAS u32x2*)(vp + 8); const u32x4 aw = {lo.x, lo.y, hi.x, hi.y};
              o0 = __builtin_amdgcn_mfma_f32_32x32x16_bf16(__builtin_bit_cast(bf16x8, aw), pb, o0, 0, 0, 0); }
            { const u32x2 lo = *(const LAS u32x2*)(vp + 32 * AT_VSTR), hi = *(const LAS u32x2*)(vp + 32 * AT_VSTR + 8); const u32x4 aw = {lo.x, lo.y, hi.x, hi.y};
              o1 = __builtin_amdgcn_mfma_f32_32x32x16_bf16(__builtin_bit_cast(bf16x8, aw), pb, o1, 0, 0, 0); }
        }
#pragma unroll
    for (int rg = 0; rg < 4; ++rg) {
        u32x2 w0, w1;
        w0.x = pk2(o0[4 * rg] * inv, o0[4 * rg + 1] * inv); w0.y = pk2(o0[4 * rg + 2] * inv, o0[4 * rg + 3] * inv);
        w1.x = pk2(o1[4 * rg] * inv, o1[4 * rg + 1] * inv); w1.y = pk2(o1[4 * rg + 2] * inv, o1[4 * rg + 3] * inv);
        *(u32x2*)(orow + 8 * rg + 4 * h) = w0; *(u32x2*)(orow + 32 + 8 * rg + 4 * h) = w1;
    }
}

__device__ __forceinline__ void phase_attn(const bf16_t* QKV, bf16_t* O, const float* ck, const float* cv, const float* rel_bias, const float* sinks,
                                           float* kS, float* vS, LAS unsigned char* lds, int tid, int wave, int lane) {
    LAS float* tbl = (LAS float*)(lds + AT_TBL);
    LAS bf16_t* Ks = (LAS bf16_t*)(lds + AT_K);
    LAS bf16_t* Vts = (LAS bf16_t*)(lds + AT_V);
    for (int i = tid; i < 16 * 192; i += NTHREADS) { const int hd = i / 192, dist = (i - hd * 192) - 31; tbl[i] = (dist >= 0 && dist < WIN) ? rel_bias[t5_bucket(dist) * NHQ + hd] : -INFINITY; }
    const int l31 = lane & 31, h = lane >> 5;
    for (int u = blockIdx.x; u < 1024; u += gridDim.x) {
        __syncthreads();
        if (u < 512) {
            const int kv = u & 3, qb = (u >> 2) & 15, b = u >> 6;
            const int prow0 = b * PL + qb * 128 - 128;
#pragma unroll
            for (int i = 0; i < 4; ++i) { const int pi = tid + NTHREADS * i, r = pi >> 3, c = pi & 7;
                u32x4 v = {0u, 0u, 0u, 0u};
                if (qb > 0 || r >= 128) v = *(const u32x4*)(QKV + (size_t)(prow0 + r) * QKV_N + KCOL + kv * HD + c * 8);
                *(LAS u32x4*)(Ks + r * AT_KSTR + c * 8) = v; }
#pragma unroll
            for (int i = 0; i < 2; ++i) { const int task = tid + NTHREADS * i, kp = task >> 3, dc = task & 7;
                u32x4 v0 = {0u, 0u, 0u, 0u}, v1 = v0;
                if (qb > 0 || kp >= 64) { const bf16_t* vp = QKV + (size_t)(prow0 + 2 * kp) * QKV_N + VCOL + kv * HD + dc * 8; v0 = *(const u32x4*)vp; v1 = *(const u32x4*)(vp + QKV_N); }
                LAS unsigned* d = (LAS unsigned*)(Vts + (dc * 8) * AT_VSTR + 2 * kp);
                d[0 * (AT_VSTR / 2)] = (v0.x & 0xffffu) | (v1.x << 16); d[1 * (AT_VSTR / 2)] = (v0.x >> 16) | (v1.x & 0xffff0000u);
                d[2 * (AT_VSTR / 2)] = (v0.y & 0xffffu) | (v1.y << 16); d[3 * (AT_VSTR / 2)] = (v0.y >> 16) | (v1.y & 0xffff0000u);
                d[4 * (AT_VSTR / 2)] = (v0.z & 0xffffu) | (v1.z << 16); d[5 * (AT_VSTR / 2)] = (v0.z >> 16) | (v1.z & 0xffff0000u);
                d[6 * (AT_VSTR / 2)] = (v0.w & 0xffffu) | (v1.w << 16); d[7 * (AT_VSTR / 2)] = (v0.w >> 16) | (v1.w & 0xffff0000u); }
            __syncthreads();
            const int g = wave >> 1, qh = wave & 1, head = kv * 4 + g;
            const float sink = sinks[head];
#pragma unroll 1
            for (int sbk = 0; sbk < 2; ++sbk) {
                const int q0 = qh * 64 + sbk * 32;
                const size_t row = (size_t)b * PL + qb * 128 + q0 + l31;
                bf16x8 qf[4];
#pragma unroll
                for (int ds = 0; ds < 4; ++ds) qf[ds] = *(const bf16x8*)(QKV + row * QKV_N + head * HD + 16 * ds + 8 * h);
                attn_sub(Ks, Vts, tbl + head * 192, qf, q0, q0 + l31 + 128, qb == 0 ? 128 : 0, sink, O + row * D + head * HD, lane);
            }
        } else {
            const int us = u - 512, kv = us & 3, b = us >> 2;
            for (int pi = tid; pi < 160 * 8; pi += NTHREADS) { const int r = pi >> 3, c = pi & 7;
                u32x4 kw = {0u, 0u, 0u, 0u}, v0 = kw;
                if (r < WIN) { const size_t src = ((size_t)(b * WIN + r) * NKV + kv) * HD + c * 8;
                    const f32x4 a = *(const f32x4*)(ck + src), a2 = *(const f32x4*)(ck + src + 4), e = *(const f32x4*)(cv + src), e2 = *(const f32x4*)(cv + src + 4);
                    kw.x = pk2(a[0], a[1]); kw.y = pk2(a[2], a[3]); kw.z = pk2(a2[0], a2[1]); kw.w = pk2(a2[2], a2[3]);
                    v0.x = pk2(e[0], e[1]); v0.y = pk2(e[2], e[3]); v0.z = pk2(e2[0], e2[1]); v0.w = pk2(e2[2], e2[3]);
                    if (r >= SL) { const size_t dst = ((size_t)(b * WIN + r - SL) * NKV + kv) * HD + c * 8;
                        *(f32x4*)(kS + dst) = a; *(f32x4*)(kS + dst + 4) = a2; *(f32x4*)(vS + dst) = e; *(f32x4*)(vS + dst + 4) = e2; }
                } else if (r < WIN + SL) { const bf16_t* p = QKV + (size_t)(MP + b * SL + (r - WIN)) * QKV_N + kv * HD + c * 8; kw = *(const u32x4*)(p + KCOL); v0 = *(const u32x4*)(p + VCOL); }
                *(LAS u32x4*)(Ks + r * AT_KSTR + c * 8) = kw;
                LAS bf16_t* d = Vts + (c * 8) * AT_VSTR + r;
                d[0 * AT_VSTR] = (bf16_t)(v0.x & 0xffffu); d[1 * AT_VSTR] = (bf16_t)(v0.x >> 16); d[2 * AT_VSTR] = (bf16_t)(v0.y & 0xffffu); d[3 * AT_VSTR] = (bf16_t)(v0.y >> 16);
                d[4 * AT_VSTR] = (bf16_t)(v0.z & 0xffffu); d[5 * AT_VSTR] = (bf16_t)(v0.z >> 16); d[6 * AT_VSTR] = (bf16_t)(v0.w & 0xffffu); d[7 * AT_VSTR] = (bf16_t)(v0.w >> 16); }
            __syncthreads();
            if (wave == 0) {
                const int g = l31 >> 3, si = l31 & 7, head = kv * 4 + g;
                const size_t row = (size_t)MP + b * SL + si;
                bf16x8 qf[4];
#pragma unroll
                for (int ds = 0; ds < 4; ++ds) qf[ds] = *(const bf16x8*)(QKV + row * QKV_N + head * HD + 16 * ds + 8 * h);
                attn_sub(Ks, Vts, tbl + head * 192, qf, 0, 128 + si, 0, sinks[head], O + row * D + head * HD, lane);
            }
        }
    }
}

constexpr int SS_PT = 136;
constexpr int SS_BRM = 0, SS_CRM = 128 * SS_PT * 2, SS_BT = 2 * 128 * SS_PT * 2, SS_XT = 3 * 128 * SS_PT * 2, SS_H = SS_XT + 64 * SS_PT * 2, SS_F = SS_H + 64 * SS_PT * 2, SS_END = SS_F + 4 * 128 * 4;
static_assert(SS_END <= RING_BYTES, "SSD LDS");

template <int NS, int HALF, bool ROWS>
__device__ __forceinline__ void conv4(const u32x4 (&raw)[NS + 3], const float* conv_w, const float* conv_b, int cc, LAS bf16_t* rm, unsigned (&qT)[4][NS / 2]) {
    const f32x4 w0 = *(const f32x4*)(conv_w + cc), w1 = *(const f32x4*)(conv_w + CONV_D + cc), w2 = *(const f32x4*)(conv_w + 2 * CONV_D + cc), w3 = *(const f32x4*)(conv_w + 3 * CONV_D + cc), cb = *(const f32x4*)(conv_b + cc);
#define UNPK4(dst, q) do { const unsigned a_ = HALF ? q.z : q.x, b_ = HALF ? q.w : q.y; dst[0] = bflo(a_); dst[1] = bfhi(a_); dst[2] = bflo(b_); dst[3] = bfhi(b_); } while (0)
    f32x4 r0, r1, r2, r3, prev;
    UNPK4(r0, raw[0]); UNPK4(r1, raw[1]); UNPK4(r2, raw[2]);
#pragma unroll
    for (int i = 0; i < NS; ++i) {
        UNPK4(r3, raw[i + 3]);
        f32x4 v = cb + w0 * r0 + w1 * r1 + w2 * r2 + w3 * r3;
        v[0] = silu_f(v[0]); v[1] = silu_f(v[1]); v[2] = silu_f(v[2]); v[3] = silu_f(v[3]);
        r0 = r1; r1 = r2; r2 = r3;
        if (ROWS) { u32x2 q; q.x = pk2(v[0], v[1]); q.y = pk2(v[2], v[3]); *(LAS u32x2*)(rm + i * SS_PT) = q; }
        if (i & 1) { qT[0][i >> 1] = pk2(prev[0], v[0]); qT[1][i >> 1] = pk2(prev[1], v[1]); qT[2][i >> 1] = pk2(prev[2], v[2]); qT[3][i >> 1] = pk2(prev[3], v[3]); } else prev = v;
    }
#undef UNPK4
}
__device__ __forceinline__ void ssd_prompt_unit(KP P, LAS unsigned char* lds, int b, int h, int tid_in, int wave, int lane_in) {
    int tid = tid_in, lane = lane_in;
    const bf16_t* ZX = (const bf16_t*)(P->ws + WS_ZX); bf16_t* Y = (bf16_t*)(P->ws + WS_Y);
    const float* conv_w = P->in[14]; const float* conv_b = P->in[15];
    LAS bf16_t* Brm = (LAS bf16_t*)(lds + SS_BRM); LAS bf16_t* Crm = (LAS bf16_t*)(lds + SS_CRM); LAS bf16_t* Bt = (LAS bf16_t*)(lds + SS_BT);
    LAS bf16_t* Xt = (LAS bf16_t*)(lds + SS_XT); LAS bf16_t* Hs = (LAS bf16_t*)(lds + SS_H);
    LAS float* dtv = (LAS float*)(lds + SS_F); LAS float* acum = dtv + 128; LAS float* ea = acum + 128; LAS float* dec = ea + 128;
    const int g = h >> 3;
    const int tt = wave >> 1, pt = wave & 1;
    const float a = -__expf(P->in[17][h]), dtb = P->in[16][h], Dh = P->in[18][h];
    const size_t row0 = (size_t)b * PL;
    for (int i = tid; i < 64 * SS_PT / 2; i += NTHREADS) ((LAS unsigned*)Hs)[i] = 0u;
    f32x16 hacc = {0.f, 0.f, 0.f, 0.f, 0.f, 0.f, 0.f, 0.f, 0.f, 0.f, 0.f, 0.f, 0.f, 0.f, 0.f, 0.f};
#pragma unroll 1
    for (int c = 0; c < PL / 128; ++c) {
        const size_t rowc = row0 + (size_t)c * 128;
        asm volatile("" : "+v"(tid), "+v"(lane));
        const int l31 = lane & 31, hh = lane >> 5;
        {
            const int cg = tid & 31, seg = tid >> 5, isC = cg >> 4, n0 = (cg & 15) * 8;
            const int cc = DI + isC * 512 + g * 128 + n0;
            const bf16_t* src = ZX + (rowc + seg * 8) * SSM_INP + XBC_COL + cc;
            const int xcg = tid & 7, xs2 = tid >> 3, p0 = xcg * 8;
            const int xcc = h * 64 + p0;
            const bf16_t* xsrc = ZX + (rowc + xs2 * 2) * SSM_INP + XBC_COL + xcc;
            u32x4 raw[11], xraw[5];
#pragma unroll
            for (int i = 0; i < 11; ++i) raw[i] = (c == 0 && seg == 0 && i < 3) ? (u32x4){0u, 0u, 0u, 0u} : *(const u32x4*)(src + (ptrdiff_t)(i - 3) * SSM_INP);
#pragma unroll
            for (int i = 0; i < 5; ++i) xraw[i] = (c == 0 && xs2 * 2 - 3 + i < 0) ? (u32x4){0u, 0u, 0u, 0u} : *(const u32x4*)(xsrc + (ptrdiff_t)(i - 3) * SSM_INP);
            LAS bf16_t* rm = (isC ? Crm : Brm) + (seg * 8) * SS_PT + n0;
            unsigned qT[4][4];
            conv4<8, 0, true>(raw, conv_w, conv_b, cc, rm, qT);
            if (!isC) {
#pragma unroll
                for (int j = 0; j < 4; ++j) *(LAS u32x4*)(Bt + (n0 + j) * SS_PT + seg * 8) = (u32x4){qT[j][0], qT[j][1], qT[j][2], qT[j][3]};
            }
            __builtin_amdgcn_sched_barrier(0);
            conv4<8, 1, true>(raw, conv_w, conv_b, cc + 4, rm + 4, qT);
            if (!isC) {
#pragma unroll
                for (int j = 0; j < 4; ++j) *(LAS u32x4*)(Bt + (n0 + 4 + j) * SS_PT + seg * 8) = (u32x4){qT[j][0], qT[j][1], qT[j][2], qT[j][3]};
            }
            __builtin_amdgcn_sched_barrier(0);
            unsigned qx[4][1];
            conv4<2, 0, false>(xraw, conv_w, conv_b, xcc, nullptr, qx);
#pragma unroll
            for (int j = 0; j < 4; ++j) *(LAS unsigned*)(Xt + (p0 + j) * SS_PT + xs2 * 2) = qx[j][0];
            conv4<2, 1, false>(xraw, conv_w, conv_b, xcc + 4, nullptr, qx);
#pragma unroll
            for (int j = 0; j < 4; ++j) *(LAS unsigned*)(Xt + (p0 + 4 + j) * SS_PT + xs2 * 2) = qx[j][0];
        }
        if (wave == 0) {
            const float r0 = bf1(ZX[(rowc + 2 * lane) * SSM_INP + DT_COL + h]) + dtb, r1 = bf1(ZX[(rowc + 2 * lane + 1) * SSM_INP + DT_COL + h]) + dtb;
            const float d0 = r0 > 20.f ? r0 : log1pf(__expf(r0)), d1 = r1 > 20.f ? r1 : log1pf(__expf(r1));
            const float c0 = d0 * a, c1 = c0 + d1 * a;
            float inc = c1;
#pragma unroll
            for (int o2 = 1; o2 < 64; o2 <<= 1) { const float v = __shfl_up(inc, o2); if (lane >= o2) inc += v; }
            const float pre = inc - c1, a0 = pre + c0, a1 = pre + c1;
            const float tot = __shfl(inc, 63);
            dtv[2 * lane] = d0; dtv[2 * lane + 1] = d1; acum[2 * lane] = a0; acum[2 * lane + 1] = a1;
            ea[2 * lane] = __expf(a0); ea[2 * lane + 1] = __expf(a1);
            dec[2 * lane] = __expf(tot - a0) * d0; dec[2 * lane + 1] = __expf(tot - a1) * d1;
        }
        __syncthreads();
        const int tcol = 32 * tt + l31;
        const float acum_t = acum[tcol];
        f32x16 yA = {0.f, 0.f, 0.f, 0.f, 0.f, 0.f, 0.f, 0.f, 0.f, 0.f, 0.f, 0.f, 0.f, 0.f, 0.f, 0.f}, yB = yA;
#pragma unroll 1
        for (int st = 0; st <= tt; ++st) {
            f32x16 gacc = {0.f, 0.f, 0.f, 0.f, 0.f, 0.f, 0.f, 0.f, 0.f, 0.f, 0.f, 0.f, 0.f, 0.f, 0.f, 0.f};
#pragma unroll
            for (int ks = 0; ks < 8; ++ks) {
                const bf16x8 av = *(const LAS bf16x8*)(Brm + (32 * st + l31) * SS_PT + 16 * ks + 8 * hh);
                const bf16x8 bv = *(const LAS bf16x8*)(Crm + tcol * SS_PT + 16 * ks + 8 * hh);
                gacc = __builtin_amdgcn_mfma_f32_32x32x16_bf16(av, bv, gacc, 0, 0, 0);
            }
            float wv[16];
#pragma unroll
            for (int rg = 0; rg < 4; ++rg) {
                const int s0 = 32 * st + 8 * rg + 4 * hh;
                const f32x4 as = *(const LAS f32x4*)(acum + s0), ds = *(const LAS f32x4*)(dtv + s0);
#pragma unroll
                for (int e = 0; e < 4; ++e) { const float v = gacc[4 * rg + e] * __expf(acum_t - as[e]) * ds[e]; wv[4 * rg + e] = (s0 + e <= tcol) ? v : 0.f; }
            }
#pragma unroll
            for (int s2 = 0; s2 < 2; ++s2) {
                u32x4 pw; pw.x = pk2(wv[8 * s2 + 0], wv[8 * s2 + 1]); pw.y = pk2(wv[8 * s2 + 2], wv[8 * s2 + 3]); pw.z = pk2(wv[8 * s2 + 4], wv[8 * s2 + 5]); pw.w = pk2(wv[8 * s2 + 6], wv[8 * s2 + 7]);
                const LAS bf16_t* xp = Xt + (32 * pt + l31) * SS_PT + 32 * st + 16 * s2 + 4 * hh;
                const u32x2 lo = *(const LAS u32x2*)xp, hi = *(const LAS u32x2*)(xp + 8); const u32x4 xw = {lo.x, lo.y, hi.x, hi.y};
                yA = __builtin_amdgcn_mfma_f32_32x32x16_bf16(__builtin_bit_cast(bf16x8, pw), __builtin_bit_cast(bf16x8, xw), yA, 0, 0, 0);
            }
        }
#pragma unroll
        for (int ks = 0; ks < 8; ++ks) {
            const bf16x8 av = *(const LAS bf16x8*)(Crm + tcol * SS_PT + 16 * ks + 8 * hh);
            const bf16x8 bv = *(const LAS bf16x8*)(Hs + (32 * pt + l31) * SS_PT + 16 * ks + 8 * hh);
            yB = __builtin_amdgcn_mfma_f32_32x32x16_bf16(av, bv, yB, 0, 0, 0);
        }
        {
            const int pcol = 32 * pt + l31;
            bf16_t* yo = Y + rowc * DI + h * 64 + pcol;
#pragma unroll
            for (int rg = 0; rg < 4; ++rg) {
                const int t0 = 32 * tt + 8 * rg + 4 * hh;
                const f32x4 ev = *(const LAS f32x4*)(ea + t0);
                const u32x2 xw = *(const LAS u32x2*)(Xt + pcol * SS_PT + t0);
                const float x0 = bflo(xw.x), x1 = bfhi(xw.x), x2 = bflo(xw.y), x3 = bfhi(xw.y);
                yo[(size_t)(t0 + 0) * DI] = (bf16_t)f2bf(yA[4 * rg + 0] + ev[0] * yB[4 * rg + 0] + Dh * x0);
                yo[(size_t)(t0 + 1) * DI] = (bf16_t)f2bf(yA[4 * rg + 1] + ev[1] * yB[4 * rg + 1] + Dh * x1);
                yo[(size_t)(t0 + 2) * DI] = (bf16_t)f2bf(yA[4 * rg + 2] + ev[2] * yB[4 * rg + 2] + Dh * x2);
                yo[(size_t)(t0 + 3) * DI] = (bf16_t)f2bf(yA[4 * rg + 3] + ev[3] * yB[4 * rg + 3] + Dh * x3);
            }
        }
        {
            const float eT = ea[127];
#pragma unroll
            for (int r = 0; r < 16; ++r) hacc[r] *= eT;
#pragma unroll
            for (int ks = 0; ks < 8; ++ks) {
                const bf16x8 av = *(const LAS bf16x8*)(Bt + (32 * tt + l31) * SS_PT + 16 * ks + 8 * hh);
                const u32x4 xw = *(const LAS u32x4*)(Xt + (32 * pt + l31) * SS_PT + 16 * ks + 8 * hh);
                const f32x4 d0 = *(const LAS f32x4*)(dec + 16 * ks + 8 * hh), d1 = *(const LAS f32x4*)(dec + 16 * ks + 8 * hh + 4);
                u32x4 bw; bw.x = pk2(bflo(xw.x) * d0[0], bfhi(xw.x) * d0[1]); bw.y = pk2(bflo(xw.y) * d0[2], bfhi(xw.y) * d0[3]);
                bw.z = pk2(bflo(xw.z) * d1[0], bfhi(xw.z) * d1[1]); bw.w = pk2(bflo(xw.w) * d1[2], bfhi(xw.w) * d1[3]);
                hacc = __builtin_amdgcn_mfma_f32_32x32x16_bf16(av, __builtin_bit_cast(bf16x8, bw), hacc, 0, 0, 0);
            }
        }
        __syncthreads();
#pragma unroll
        for (int rg = 0; rg < 4; ++rg) { u32x2 w; w.x = pk2(hacc[4 * rg], hacc[4 * rg + 1]); w.y = pk2(hacc[4 * rg + 2], hacc[4 * rg + 3]);
            *(LAS u32x2*)(Hs + (32 * pt + l31) * SS_PT + 32 * tt + 8 * rg + 4 * hh) = w; }
    }
    const int l31 = lane & 31, hh = lane >> 5;
    float* ho = P->out + O_SP + (((size_t)b * SH + h) * SP + 32 * pt + l31) * SN + 32 * tt + 4 * hh;
#pragma unroll
    for (int rg = 0; rg < 4; ++rg) *(f32x4*)(ho + 8 * rg) = (f32x4){hacc[4 * rg], hacc[4 * rg + 1], hacc[4 * rg + 2], hacc[4 * rg + 3]};
    __syncthreads();
}

__device__ __forceinline__ void ssd_sample_unit(KP P, LAS unsigned char* lds, int b, int h, int tid) {
    const bf16_t* ZX = (const bf16_t*)(P->ws + WS_ZX); bf16_t* Y = (bf16_t*)(P->ws + WS_Y);
    const float* conv_w = P->in[14]; const float* conv_b = P->in[15]; const float* st_conv = P->in[4]; const float* st_ssm = P->in[5];
    LAS float* xs = (LAS float*)lds;
    LAS float* Bs = xs + SL * 64;
    LAS float* Cs = Bs + SL * 128;
    LAS float* ys = Cs + SL * 128;
    LAS float* dts = ys + SL * 64;
    LAS float* dAs = dts + SL;
    const int p = tid >> 3, nb = tid & 7, g = h >> 3;
    const size_t row0 = (size_t)MP + b * SL;
    const float a = -__expf(P->in[17][h]), dtb = P->in[16][h], Dh = P->in[18][h];
    float hr[16];
    const size_t hoff = (((size_t)b * SH + h) * SP + p) * SN + nb * 16;
#pragma unroll
    for (int i = 0; i < 4; ++i) { const f32x4 v = *(const f32x4*)(st_ssm + hoff + 4 * i); hr[4 * i] = v[0]; hr[4 * i + 1] = v[1]; hr[4 * i + 2] = v[2]; hr[4 * i + 3] = v[3]; }
#pragma unroll
    for (int k = 0; k < 5; ++k) {
        const int idx = tid + NTHREADS * k, t = idx / 320, ch = idx - t * 320;
        const int cc = ch < 64 ? h * 64 + ch : (ch < 192 ? DI + g * 128 + (ch - 64) : DI + 512 + g * 128 + (ch - 192));
        float v = conv_b[cc];
#pragma unroll
        for (int j = 0; j < 4; ++j) {
            const int tt = t - 3 + j;
            const float r = (tt >= 0) ? bf1(ZX[(row0 + tt) * SSM_INP + XBC_COL + cc]) : st_conv[((size_t)b * 3 + (3 + tt)) * CONV_D + cc];
            v += conv_w[j * CONV_D + cc] * r;
        }
        v = silu_f(v);
        if (ch < 64) xs[t * 64 + ch] = v; else if (ch < 192) Bs[t * 128 + (ch - 64)] = v; else Cs[t * 128 + (ch - 192)] = v;
    }
    if (tid < SL) {
        const float raw = bf1(ZX[(row0 + tid) * SSM_INP + DT_COL + h]) + dtb;
        const float dtv = raw > 20.f ? raw : log1pf(__expf(raw));
        dts[tid] = dtv; dAs[tid] = __expf(dtv * a);
    }
    __syncthreads();
#pragma unroll
    for (int t = 0; t < SL; ++t) {
        const float dA = dAs[t], xv = xs[t * 64 + p], xdt = xv * dts[t];
        float acc = 0.f;
#pragma unroll
        for (int i = 0; i < 4; ++i) {
            const f32x4 Bv = *(const LAS f32x4*)(Bs + t * 128 + nb * 16 + 4 * i), Cv = *(const LAS f32x4*)(Cs + t * 128 + nb * 16 + 4 * i);
#pragma unroll
            for (int e = 0; e < 4; ++e) { hr[4 * i + e] = hr[4 * i + e] * dA + xdt * Bv[e]; acc += Cv[e] * hr[4 * i + e]; }
        }
        acc += __shfl_xor(acc, 1); acc += __shfl_xor(acc, 2); acc += __shfl_xor(acc, 4);
        if (nb == 0) ys[t * 64 + p] = acc + Dh * xv;
    }
    float* ho = P->out + O_SS + hoff;
#pragma unroll
    for (int i = 0; i < 4; ++i) *(f32x4*)(ho + 4 * i) = (f32x4){hr[4 * i], hr[4 * i + 1], hr[4 * i + 2], hr[4 * i + 3]};
    __syncthreads();
    if (tid < SL * 32) { const int t = tid >> 5, c2 = (tid & 31) * 2;
        *(unsigned*)(Y + (row0 + t) * DI + h * 64 + c2) = pk2(ys[t * 64 + c2], ys[t * 64 + c2 + 1]); }
    __syncthreads();
}

__device__ __forceinline__ void phase_ssd(KP P, LAS unsigned char* lds, int tid, int wave, int lane) {
    for (int u = blockIdx.x; u < PB * SH; u += gridDim.x) ssd_prompt_unit(P, lds, u >> 5, u & 31, tid, wave, lane);
    for (int u = blockIdx.x; u < SB * SH; u += gridDim.x) ssd_sample_unit(P, lds, u >> 5, u & 31, tid);
}

__device__ __forceinline__ void phase_gnorm(KP P, int gw, int NGW, int lane) {
    const bf16_t* ZX = (const bf16_t*)(P->ws + WS_ZX); bf16_t* Y = (bf16_t*)(P->ws + WS_Y); const float* nw = P->in[19];
    for (int u0 = gw * 4; u0 < M * 4; u0 += NGW * 4) {
        u32x4 yw[4], zw[4];
#pragma unroll
        for (int k = 0; k < 4; ++k) { const int u = u0 + k, row = u >> 2, c = (u & 3) * 512 + lane * 8; yw[k] = *(const u32x4*)(Y + (size_t)row * DI + c); zw[k] = *(const u32x4*)(ZX + (size_t)row * SSM_INP + c); }
#pragma unroll
        for (int k = 0; k < 4; ++k) {
            const int u = u0 + k, row = u >> 2, c = (u & 3) * 512 + lane * 8;
            float v[8];
            v[0] = bflo(yw[k].x) * silu_f(bflo(zw[k].x)); v[1] = bfhi(yw[k].x) * silu_f(bfhi(zw[k].x)); v[2] = bflo(yw[k].y) * silu_f(bflo(zw[k].y)); v[3] = bfhi(yw[k].y) * silu_f(bfhi(zw[k].y));
            v[4] = bflo(yw[k].z) * silu_f(bflo(zw[k].z)); v[5] = bfhi(yw[k].z) * silu_f(bfhi(zw[k].z)); v[6] = bflo(yw[k].w) * silu_f(bflo(zw[k].w)); v[7] = bfhi(yw[k].w) * silu_f(bfhi(zw[k].w));
            float ss = 0.f;
#pragma unroll
            for (int e = 0; e < 8; ++e) ss += v[e] * v[e];
            const float r = 1.0f / sqrtf(wave_sum(ss) * (1.0f / 512.0f) + RMS_EPS);
            const f32x4 w0 = *(const f32x4*)(nw + c), w1 = *(const f32x4*)(nw + c + 4);
            u32x4 o; o.x = pk2(v[0] * r * w0[0], v[1] * r * w0[1]); o.y = pk2(v[2] * r * w0[2], v[3] * r * w0[3]); o.z = pk2(v[4] * r * w1[0], v[5] * r * w1[1]); o.w = pk2(v[6] * r * w1[2], v[7] * r * w1[3]);
            *(u32x4*)(Y + (size_t)row * DI + c) = o;
        }
    }
}

__device__ __forceinline__ void phase_pooldiff(KP P, int gw, int NGW, int lane) {
    const float* XF = P->out; const float* spool = P->in[6]; bf16_t* DF = (bf16_t*)(P->ws + WS_DIFF);
    const int gt = gw * 64 + lane, NT = NGW * 64;
    for (int it = gt; it < (MP / 32) * 256; it += NT) {
        const int c4 = (it & 255) * 4, seg = it >> 8, w = 2 << (c4 >> 8);
        const int row0 = seg * 32, pos0 = row0 & (PL - 1);
        const float* xp = XF + (size_t)row0 * D + c4;
        f32x4 S = (f32x4){0.f, 0.f, 0.f, 0.f};
        for (int j = 1; j < w; ++j) if (pos0 - j >= 0) S += *(const f32x4*)(xp - (ptrdiff_t)j * D);
#pragma unroll 1
        for (int i0 = 0; i0 < 32; i0 += 8) {
            f32x4 xn[8], xo[8];
#pragma unroll
            for (int i = 0; i < 8; ++i) { xn[i] = *(const f32x4*)(xp + (size_t)(i0 + i) * D);
                xo[i] = (pos0 + i0 + i - w + 1 >= 0) ? *(const f32x4*)(xp + (ptrdiff_t)(i0 + i - w + 1) * D) : (f32x4){0.f, 0.f, 0.f, 0.f}; }
#pragma unroll
            for (int i = 0; i < 8; ++i) {
                const int pos = pos0 + i0 + i; const float cnt = (float)((pos + 1) < w ? (pos + 1) : w);
                S += xn[i];
                const f32x4 d = S / cnt - xn[i];
                S -= xo[i];
                u32x2 o; o.x = pk2(d[0], d[1]); o.y = pk2(d[2], d[3]);
                *(u32x2*)(DF + (size_t)(row0 + i0 + i) * D + c4) = o;
            }
        }
    }
    for (int it = gt; it < SB * 256; it += NT) {
        const int c4 = (it & 255) * 4, b = it >> 8, w = 2 << (c4 >> 8);
        f32x4 xr[23];
#pragma unroll
        for (int r = 0; r < 15; ++r) xr[r] = *(const f32x4*)(spool + ((size_t)b * 15 + r) * D + c4);
#pragma unroll
        for (int r = 0; r < 8; ++r) xr[15 + r] = *(const f32x4*)(XF + (size_t)(MP + b * SL + r) * D + c4);
        const float inv = 1.0f / (float)w;
#pragma unroll
        for (int i = 0; i < 8; ++i) {
            f32x4 s = xr[15 + i];
#pragma unroll
            for (int j = 1; j < 16; ++j) if (j < w) s += xr[15 + i - j];
            const f32x4 d = s * inv - xr[15 + i];
            u32x2 o; o.x = pk2(d[0], d[1]); o.y = pk2(d[2], d[3]);
            *(u32x2*)(DF + (size_t)(MP + b * SL + i) * D + c4) = o;
        }
#pragma unroll
        for (int r = 0; r < 15; ++r) *(f32x4*)(P->out + O_PS + ((size_t)b * 15 + r) * D + c4) = xr[8 + r];
    }
    for (int i = gt; i < PB * 15 * 256; i += NT) { const int c4 = (i & 255) * 4, r = (i >> 8) % 15, b = (i >> 8) / 15;
        *(f32x4*)(P->out + O_PP + ((size_t)b * 15 + r) * D + c4) = *(const f32x4*)(XF + (size_t)(b * PL + PL - 15 + r) * D + c4); }
}

typedef GAS unsigned gu32;
#define XB_TMO      128
#define XB_XCNT(j)  (256  + 64 * (j))
#define XB_XSUB(j)  (1280 + 64 * (j))
#define XB_XGEN(j)  (2304 + 64 * (j))
#define XB_TOP      3328
#define XB_TOPGEN   3392
#define XCD_BAR_WORDS 3456
#define XB_SPIN_CAP (1u << 18)
__device__ __forceinline__ unsigned xb_ld(unsigned* p)              { return __hip_atomic_load(p, __ATOMIC_RELAXED, __HIP_MEMORY_SCOPE_AGENT); }
__device__ __forceinline__ unsigned xb_add(unsigned* p, unsigned v) { return __hip_atomic_fetch_add(p, v, __ATOMIC_RELAXED, __HIP_MEMORY_SCOPE_AGENT); }
__device__ __forceinline__ unsigned xb_xcc_id() { return (unsigned)__builtin_amdgcn_s_getreg((3 << 11) | 20) & 0xFu; }
#define XB_SPIN(cond, bar) do { unsigned _sp = 0; while (cond) { __builtin_amdgcn_s_sleep(1); \
    if ((++_sp & 255u) == 0u) { if (xb_ld(&(bar)[XB_TMO])) break; if (_sp > XB_SPIN_CAP) { atomicAdd(&(bar)[XB_TMO], 1u); break; } } } } while (0)
struct XcdBarrier { unsigned* bar; unsigned x; volatile LAS unsigned* st; };
__device__ __forceinline__ XcdBarrier xcd_barrier_post(unsigned* bar, volatile LAS unsigned* st) {
    XcdBarrier b; b.bar = bar; b.x = xb_xcc_id(); b.st = st;
    if (threadIdx.x == 0) (void)xb_add(&bar[XB_XCNT(b.x)], 1u);
    return b;
}
__device__ __forceinline__ void xcd_barrier_complete(unsigned* bar, unsigned x, unsigned& nloc, unsigned& nx) {
    const unsigned G = gridDim.x * gridDim.y * gridDim.z;
    unsigned sum, cnt, mine, sp = 0u;
    for (;;) {
        sum = 0u; cnt = 0u; mine = 0u;
#pragma unroll
        for (unsigned j = 0; j < 16; ++j) { const unsigned c = xb_ld(&bar[XB_XCNT(j)]); sum += c; cnt += (c > 0u) ? 1u : 0u; mine = (j == x) ? c : mine; }
        if (sum == G) break;
        __builtin_amdgcn_s_sleep(1);
        if ((++sp & 255u) == 0u) { if (xb_ld(&bar[XB_TMO])) break; if (sp > XB_SPIN_CAP) { atomicAdd(&bar[XB_TMO], 1u); break; } }
    }
    nloc = mine > 0u ? mine : 1u; nx = cnt > 0u ? cnt : 1u;
}
__device__ __forceinline__ void xcd_barrier(const XcdBarrier& b) {
    asm volatile("s_waitcnt vmcnt(0)" ::: "memory");
    __syncthreads();
    if (threadIdx.x == 0) {
        unsigned* bar = b.bar;
        __builtin_amdgcn_s_waitcnt(0);
        unsigned nloc = b.st[0], nx = b.st[1];
        if (nloc == 0u) { xcd_barrier_complete(bar, b.x, nloc, nx); b.st[0] = nloc; b.st[1] = nx; }
        const unsigned old = xb_add(&bar[XB_XSUB(b.x)], 1u);
        const unsigned gen = old / nloc;
        if (old + 1u == (gen + 1u) * nloc) {
            __builtin_amdgcn_fence(__ATOMIC_RELEASE, "agent");
            asm volatile("s_waitcnt vmcnt(0)" ::: "memory");
            const unsigned og = xb_add(&bar[XB_TOP], 1u);
            const unsigned tg = og / nx;
            if (og + 1u == (tg + 1u) * nx) xb_add(&bar[XB_TOPGEN], 1u);
            else XB_SPIN(xb_ld(&bar[XB_TOPGEN]) == tg, bar);
            __builtin_amdgcn_fence(__ATOMIC_ACQUIRE, "agent");
            xb_add(&bar[XB_XGEN(b.x)], 1u);
            asm volatile("s_waitcnt vmcnt(0)" ::: "memory");
        } else {
            XB_SPIN(xb_ld(&bar[XB_XGEN(b.x)]) == gen, bar);
            __builtin_amdgcn_fence(__ATOMIC_ACQUIRE, "agent");
            asm volatile("s_waitcnt vmcnt(0)" ::: "memory");
        }
    }
    __syncthreads();
}

#ifndef MK_PER_PHASE
#define MK_PER_PHASE 0
#endif
constexpr int N_PHASES = 29;
enum { OP_PREP = 0, OP_GEMM_SIDE, OP_ATTN, OP_GEMM_RES, OP_LN, OP_GEMM_UP, OP_SSD, OP_GNORM, OP_DIFF };

__global__ void __launch_bounds__(NTHREADS, 2) fwd_kernel(Ptrs Parg) {
    extern __shared__ __attribute__((aligned(16))) unsigned char lds_raw[];
    LAS unsigned char* lds = (LAS unsigned char*)lds_raw;
    const int ph_lo = Parg.ph_lo, ph_hi = Parg.ph_hi;
    {
        const int tid0 = threadIdx.x;
        for (int u = tid0; u < (LDS_BYTES - RING_BYTES) / 4; u += NTHREADS) ((LAS unsigned*)(lds + RING_BYTES))[u] = 0u;
        __syncthreads();
        if (ph_hi - ph_lo > 1) { if (tid0 == 0) (void)xb_add(&((unsigned*)(Parg.ws + WS_CTL) + 4096)[XB_XCNT(xb_xcc_id())], 1u); }
    }
    bool probe_rep = false;
    for (int ph = ph_lo; ph < ph_hi; ++ph) {
        int tid = threadIdx.x; asm volatile("" : "+v"(tid));
        KP P = (KP)__builtin_amdgcn_kernarg_segment_ptr(); asm volatile("" : "+s"(P));
        int bx = blockIdx.x; asm volatile("" : "+s"(bx));
        const int lane = tid & 63, wave = __builtin_amdgcn_readfirstlane(tid >> 6);
        const int G = gridDim.x;
        const int vcu = (G % 8 == 0) ? (bx % 8) * (G / 8) + bx / 8 : bx;
        const int gw = vcu * NWAVES + wave, NGW = G * NWAVES;
        unsigned char* ws = P->ws;
        bf16_t* XB = (bf16_t*)(ws + WS_XB);
        float* Z = (float*)(ws + WS_Z);
        float* XF = P->out;
        int op = OP_PREP, L = 0, t = 0;
        if (ph > 0) {
            const int q = ph - 1; int sub;
            if (q < 7) { L = 0; sub = q; } else if (q < 15) { L = 1; sub = q - 7; } else if (q < 21) { L = 2; sub = q - 15; } else { L = 3; sub = q - 21; }
            const int kind = L == 1 ? 1 : (L == 2 ? 2 : 0);
            const int npre = kind == 0 ? 2 : (kind == 1 ? 3 : 1);
            if (sub < npre) { op = kind == 0 ? (sub == 0 ? OP_GEMM_SIDE : OP_ATTN) : (kind == 1 ? (sub == 0 ? OP_GEMM_SIDE : (sub == 1 ? OP_SSD : OP_GNORM)) : OP_DIFF); }
            else { t = sub - npre; op = (t == 0 || t == 3) ? OP_GEMM_RES : ((t == 1 || t == 4) ? OP_LN : OP_GEMM_UP); }
        }
        const int kind = L == 1 ? 1 : (L == 2 ? 2 : 0);
        const int j = L / 3;
#ifndef ONLY_OP
#define ONLY_OP -1
#endif
#define EN(o) (ONLY_OP < 0 || ONLY_OP == (o))
#ifndef PROBE_MASK
#define PROBE_MASK 0
#endif
        if (EN(OP_PREP) && op == OP_PREP) {
            phase_prep(P, lds, gw, NGW, wave, lane);
        } else if (EN(OP_GEMM_SIDE) && op == OP_GEMM_SIDE) {
            pg8::Gemm g; pg8::EpiBf16Side E;
            g.A = XB; g.M = M; g.K = D; g.lda = D; g.ldb = D; g.a_pn_bytes = 0;
            E.out = P->out; E.j = j;
            if (kind == 0) { g.Bt = (const bf16_t*)(ws + WS_WQKV) + (size_t)j * QKV_N * D; g.N = QKV_N; E.O = (bf16_t*)(ws + WS_QKV); E.bias = P->in[9] + j * QKV_N; E.mode = 0; }
            else { g.Bt = (const bf16_t*)(ws + WS_WIN); g.N = SSM_INP; E.O = (bf16_t*)(ws + WS_ZX); E.bias = nullptr; E.mode = 1; }
            pg8::StaticOrder S; S.init(M, g.N, G, bx);
            pg8::gemm_phase<pg8::EpiBf16Side, pg8::StaticOrder, true, true>(lds, g, S, E, tid);
        } else if (EN(OP_ATTN) && op == OP_ATTN) {
            phase_attn((const bf16_t*)(ws + WS_QKV), (bf16_t*)(ws + WS_O), P->in[2] + (size_t)j * SB * WIN * 256, P->in[3] + (size_t)j * SB * WIN * 256, P->in[7], P->in[12] + j * NHQ,
                       P->out + O_KS + (size_t)j * SB * WIN * 256, P->out + O_VS + (size_t)j * SB * WIN * 256, lds, tid, wave, lane);
        } else if (EN(OP_GEMM_RES) && op == OP_GEMM_RES) {
            pg8::Gemm g; pg8::EpiRes E;
            g.M = M; g.N = D; g.a_pn_bytes = 0;
            E.Z = Z; E.bias = nullptr; E.scale = nullptr;
            if (L == 0 && t == 0) { E.baseP = P->in[0]; E.baseS = P->in[1]; } else { E.baseP = XF; E.baseS = XF + (size_t)MP * D; }
            if (t == 3) { g.A = (const bf16_t*)(ws + WS_H); g.lda = FF; g.Bt = (const bf16_t*)(ws + WS_WD) + (size_t)L * D * FF; g.ldb = FF; g.K = FF; }
            else if (kind == 0) { g.A = (const bf16_t*)(ws + WS_O); g.lda = D; g.Bt = (const bf16_t*)(ws + WS_WO) + (size_t)j * D * D; g.ldb = D; g.K = D; E.bias = P->in[11] + j * D; }
            else if (kind == 1) { g.A = (const bf16_t*)(ws + WS_Y); g.lda = DI; g.Bt = (const bf16_t*)(ws + WS_WOUT); g.ldb = DI; g.K = DI; }
            else { g.A = (const bf16_t*)(ws + WS_DIFF); g.lda = D; g.Bt = (const bf16_t*)(ws + WS_WPOOL); g.ldb = 256; g.K = 256; g.a_pn_bytes = 512; E.scale = P->in[22]; }
            pg8::StaticOrder S; S.init(M, D, G, bx);
            pg8::gemm_phase<pg8::EpiRes, pg8::StaticOrder, true, true>(lds, g, S, E, tid);
        } else if (EN(OP_LN) && op == OP_LN) {
            const int which = (t == 1) ? 0 : 1;
            phase_ln(Z, P->in[26] + (size_t)(L * 2 + which) * D, P->in[27] + (size_t)(L * 2 + which) * D, XF, XB, gw, NGW, lane);
        } else if (EN(OP_GEMM_UP) && op == OP_GEMM_UP) {
            pg8::Gemm g; g.A = XB; g.Bt = (const bf16_t*)(ws + WS_WGU) + (size_t)L * GU_N * D; g.M = M; g.N = GU_N; g.K = D; g.lda = D; g.ldb = D; g.a_pn_bytes = 0;
            pg8::EpiSwiGLU E; E.O = (bf16_t*)(ws + WS_H); E.ldc = FF;
            pg8::StaticOrder S; S.init(M, GU_N, G, bx);
            pg8::gemm_phase<pg8::EpiSwiGLU, pg8::StaticOrder, true, true>(lds, g, S, E, tid);
        } else if (EN(OP_SSD) && op == OP_SSD) {
            phase_ssd(P, lds, tid, wave, lane);
        } else if (EN(OP_GNORM) && op == OP_GNORM) {
            phase_gnorm(P, gw, NGW, lane);
        } else if (EN(OP_DIFF) && op == OP_DIFF) {
            phase_pooldiff(P, gw, NGW, lane);
        }
        if (PROBE_MASK) { if (((PROBE_MASK >> op) & 1) && !probe_rep) { probe_rep = true; --ph; } else probe_rep = false; }
        if (ph + 1 < ph_hi) { XcdBarrier bar; bar.bar = (unsigned*)(P->ws + WS_CTL) + 4096; bar.x = xb_xcc_id(); bar.st = (volatile LAS unsigned*)(lds + MISC_OFF) + 8; xcd_barrier(bar); }
    }
}

extern "C" void kernel_launch(void* const* d_in, const int* in_sizes, int n_in, void* d_out, int out_size, void* d_ws, size_t ws_size, hipStream_t stream) {
    static int grid = 0;
    if (grid == 0) {
        if (n_in != 28 || out_size != (int)O_END || ws_size < WS_END) { fprintf(stderr, "kernel_launch: unexpected shapes (n_in %d, out %d, ws %zu)\n", n_in, out_size, ws_size); grid = -1; return; }
        int dev = 0, cus = 0;
        if (hipGetDevice(&dev) != hipSuccess || hipDeviceGetAttribute(&cus, hipDeviceAttributeMultiprocessorCount, dev) != hipSuccess) { grid = -1; return; }
        if (hipFuncSetAttribute((const void*)fwd_kernel, hipFuncAttributeMaxDynamicSharedMemorySize, LDS_BYTES) != hipSuccess) { fprintf(stderr, "kernel_launch: hipFuncSetAttribute failed\n"); grid = -1; return; }
        (void)hipGetLastError();
        grid = cus;
    }
    if (grid < 0) return;
    (void)hipMemsetAsync((char*)d_ws + WS_CTL, 0, CTL_ZERO_BYTES, stream);
    Ptrs a{};
    for (int i = 0; i < 28; ++i) a.in[i] = (const float*)d_in[i];
    a.out = (float*)d_out; a.ws = (unsigned char*)d_ws;
#if MK_PER_PHASE
    for (int ph = 0; ph < N_PHASES; ++ph) { a.ph_lo = ph; a.ph_hi = ph + 1; hipLaunchKernelGGL(fwd_kernel, dim3(grid), dim3(NTHREADS), LDS_BYTES, stream, a); }
#else
    a.ph_lo = 0; a.ph_hi = N_PHASES;
    hipLaunchKernelGGL(fwd_kernel, dim3(grid), dim3(NTHREADS), LDS_BYTES, stream, a);
#endif
}
```
